# Optimizing an MI355X kernel written in HIP

```python
import jax, jax.numpy as jnp
from jax import lax
import numpy as np

D_MODEL = 1024
BATCH = 8
SEQ = 4096
DEPTH = 1

CONV_CH = D_MODEL
CONV_K = 3
GMLP_CH = D_MODEL
GMLP_GROUPS = 8
GMLP_GROUP_CH = GMLP_CH // GMLP_GROUPS
CHUNK = 128
MEM_LEN = 256
XA_HEADS = 4
XA_HEAD_DIM = D_MODEL // XA_HEADS
XA_WIDTH = XA_HEADS * XA_HEAD_DIM
N_BRANCH = 3
W_IN_SIZES = (CONV_CH, CONV_CH, CONV_CH, GMLP_CH, GMLP_CH, XA_WIDTH, N_BRANCH * D_MODEL)
W_IN_COLS = sum(W_IN_SIZES)
W_IN_SPLITS = tuple(int(s) for s in np.cumsum(W_IN_SIZES)[:-1])
N_EXPERTS = 32
TOP_K = 4
D_FF = D_MODEL
SWIGLU_LIMIT = 7.0
SWIGLU_ALPHA = 1.702
LN_EPS = 1e-5
DEEPNORM_ALPHA = (2 * DEPTH) ** 0.25
DEEPNORM_BETA = (8 * DEPTH) ** -0.25

kernel_name = "hybrid_conv_gmlp_xattn_moe_deepnorm"


def layer_norm(x, g, b):
    xf = x.astype(jnp.float32)
    mu = jnp.mean(xf, axis=-1, keepdims=True)
    xc = xf - mu
    var = jnp.mean(xc * xc, axis=-1, keepdims=True)
    y = xc * lax.rsqrt(var + LN_EPS) * g.astype(jnp.float32) + b.astype(jnp.float32)
    return y.astype(x.dtype)


def causal_depthwise_conv(u, w):
    c = u.shape[-1]
    return lax.conv_general_dilated(
        u, w[:, None, :].astype(u.dtype), window_strides=(1,),
        padding=((CONV_K - 1, 0),), dimension_numbers=("NWC", "WIO", "NWC"),
        feature_group_count=c)


def gmlp_spatial_gate(u, v, ws, bias, ln_g, ln_b):
    bsz, seq, _ = v.shape
    v = layer_norm(v, ln_g, ln_b)
    v = v.reshape(bsz, seq // CHUNK, CHUNK, GMLP_GROUPS, GMLP_GROUP_CH)
    ws_causal = jnp.tril(ws)
    f = jnp.einsum("gts,bnsgc->bntgc", ws_causal.astype(v.dtype), v)
    f = f + bias.T[None, None, :, :, None].astype(v.dtype)
    return u * f.reshape(bsz, seq, GMLP_CH)


def memory_cross_attention(q, mem_n, w_kv):
    bsz, seq, _ = q.shape
    k, v = jnp.split(mem_n @ w_kv, 2, axis=-1)
    q = q.reshape(bsz, seq, XA_HEADS, XA_HEAD_DIM)
    k = k.reshape(bsz, MEM_LEN, XA_HEADS, XA_HEAD_DIM)
    v = v.reshape(bsz, MEM_LEN, XA_HEADS, XA_HEAD_DIM)
    scores = jnp.einsum("bshd,bmhd->bhsm", q, k).astype(jnp.float32) * (XA_HEAD_DIM ** -0.5)
    probs = jax.nn.softmax(scores, axis=-1).astype(v.dtype)
    o = jnp.einsum("bhsm,bmhd->bshd", probs, v)
    return o.reshape(bsz, seq, XA_WIDTH)


def token_mix(h, mem_n, w_in, b_gate, conv_w, gmlp_ws, gmlp_b, gmlp_ln_g, gmlp_ln_b,
              w_kv, w_conv_proj, w_gmlp_proj, w_xa_proj, w_out):
    z = h @ w_in
    cb, cc, ch, gu, gv, q, gates = jnp.split(z, W_IN_SPLITS, axis=-1)
    y_conv = cb * causal_depthwise_conv(cc * ch, conv_w)
    y_gmlp = gmlp_spatial_gate(jax.nn.gelu(gu), jax.nn.gelu(gv), gmlp_ws, gmlp_b, gmlp_ln_g, gmlp_ln_b)
    y_xa = memory_cross_attention(q, mem_n, w_kv)
    g_conv, g_gmlp, g_xa = jnp.split(jax.nn.sigmoid(gates + b_gate), N_BRANCH, axis=-1)
    merged = (g_conv * (y_conv @ w_conv_proj)
              + g_gmlp * (y_gmlp @ w_gmlp_proj)
              + g_xa * (y_xa @ w_xa_proj))
    return merged @ w_out


def moe_ffn(h, w_router, b_router, w_gate_up, b_gate_up, w_down, b_down):
    bsz, seq, d = h.shape
    n_tok = bsz * seq
    hf = h.reshape(n_tok, d)
    logits = (hf @ w_router + b_router).astype(jnp.float32)
    top_vals, top_idx = lax.top_k(logits, TOP_K)
    gate = jax.nn.softmax(top_vals, axis=-1).astype(h.dtype)
    expert_flat = top_idx.reshape(-1)
    order = jnp.argsort(expert_flat)
    sorted_expert = expert_flat[order]
    sorted_token = order // TOP_K
    group_sizes = jnp.bincount(expert_flat, length=N_EXPERTS).astype(jnp.int32)
    xs = hf[sorted_token]
    gu = lax.ragged_dot(xs, w_gate_up, group_sizes) + b_gate_up[sorted_expert]
    g_lin, u_lin = jnp.split(gu, 2, axis=-1)
    g_lin = jnp.minimum(g_lin, SWIGLU_LIMIT)
    u_lin = jnp.clip(u_lin, -SWIGLU_LIMIT, SWIGLU_LIMIT)
    act = (u_lin + 1) * (g_lin * jax.nn.sigmoid(SWIGLU_ALPHA * g_lin))
    eo = lax.ragged_dot(act, w_down, group_sizes) + b_down[sorted_expert]
    eo = eo * gate.reshape(-1)[order][:, None]
    y = jnp.zeros_like(hf).at[sorted_token].add(eo)
    return y.reshape(bsz, seq, d)


def setup_inputs(seed: int = 0) -> dict:
    key = jax.random.key(seed)
    ks = jax.random.split(key, 28)
    L = DEPTH
    beta = DEEPNORM_BETA

    def nrm(k, shape, scale):
        return jax.random.normal(k, shape, jnp.float32) * scale

    w_k = nrm(ks[11], (L, D_MODEL, XA_WIDTH), D_MODEL ** -0.5)
    w_v = nrm(ks[12], (L, D_MODEL, XA_WIDTH), D_MODEL ** -0.5 * beta)
    return {
        "x": nrm(ks[0], (BATCH, SEQ, D_MODEL), 1.0),
        "mem": nrm(ks[1], (BATCH, MEM_LEN, D_MODEL), 1.0),
        "w_in": nrm(ks[2], (L, D_MODEL, W_IN_COLS), D_MODEL ** -0.5),
        "b_gate": nrm(ks[3], (L, N_BRANCH * D_MODEL), 0.01),
        "conv_w": nrm(ks[4], (L, CONV_K, CONV_CH), CONV_K ** -0.5),
        "gmlp_ws": nrm(ks[5], (L, GMLP_GROUPS, CHUNK, CHUNK), CHUNK ** -0.5),
        "gmlp_b": 1.0 + nrm(ks[6], (L, GMLP_GROUPS, CHUNK), 0.01),
        "gmlp_ln_g": 1.0 + nrm(ks[7], (L, GMLP_CH), 0.01),
        "gmlp_ln_b": nrm(ks[8], (L, GMLP_CH), 0.01),
        "mem_ln_g": 1.0 + nrm(ks[9], (L, D_MODEL), 0.01),
        "mem_ln_b": nrm(ks[10], (L, D_MODEL), 0.01),
        "w_kv": jnp.concatenate([w_k, w_v], axis=-1),
        "w_conv_proj": nrm(ks[13], (L, CONV_CH, D_MODEL), CONV_CH ** -0.5 * beta),
        "w_gmlp_proj": nrm(ks[14], (L, GMLP_CH, D_MODEL), GMLP_CH ** -0.5 * beta),
        "w_xa_proj": nrm(ks[15], (L, XA_WIDTH, D_MODEL), XA_WIDTH ** -0.5 * beta),
        "w_out": nrm(ks[16], (L, D_MODEL, D_MODEL), D_MODEL ** -0.5 * beta),
        "ln1_g": 1.0 + nrm(ks[17], (L, D_MODEL), 0.01),
        "ln1_b": nrm(ks[18], (L, D_MODEL), 0.01),
        "w_router": nrm(ks[19], (L, D_MODEL, N_EXPERTS), D_MODEL ** -0.5),
        "b_router": nrm(ks[20], (L, N_EXPERTS), 0.01),
        "w_gate_up": nrm(ks[21], (L, N_EXPERTS, D_MODEL, 2 * D_FF), D_MODEL ** -0.5 * beta),
        "b_gate_up": nrm(ks[22], (L, N_EXPERTS, 2 * D_FF), 0.01),
        "w_down": nrm(ks[23], (L, N_EXPERTS, D_FF, D_MODEL), D_FF ** -0.5 * beta),
        "b_down": nrm(ks[24], (L, N_EXPERTS, D_MODEL), 0.01),
        "ln2_g": 1.0 + nrm(ks[25], (L, D_MODEL), 0.01),
        "ln2_b": nrm(ks[26], (L, D_MODEL), 0.01),
    }


def reference(x, mem, w_in, b_gate, conv_w, gmlp_ws, gmlp_b, gmlp_ln_g, gmlp_ln_b,
              mem_ln_g, mem_ln_b, w_kv, w_conv_proj, w_gmlp_proj, w_xa_proj, w_out,
              ln1_g, ln1_b, w_router, b_router, w_gate_up, b_gate_up, w_down, b_down,
              ln2_g, ln2_b):
    for l in range(DEPTH):
        mem_n = layer_norm(mem, mem_ln_g[l], mem_ln_b[l])
        mix = token_mix(x, mem_n, w_in[l], b_gate[l], conv_w[l], gmlp_ws[l], gmlp_b[l],
                        gmlp_ln_g[l], gmlp_ln_b[l], w_kv[l], w_conv_proj[l],
                        w_gmlp_proj[l], w_xa_proj[l], w_out[l])
        x = layer_norm(DEEPNORM_ALPHA * x + mix, ln1_g[l], ln1_b[l])
        ffn = moe_ffn(x, w_router[l], b_router[l], w_gate_up[l], b_gate_up[l],
                      w_down[l], b_down[l])
        x = layer_norm(DEEPNORM_ALPHA * x + ffn, ln2_g[l], ln2_b[l])
    return x
```

```cpp
#include <hip/hip_runtime.h>
#include <cstdio>
#include <cstdint>

#ifndef PG8_SP2
#define PG8_SP2 true
#endif
#ifndef DUP_PHASE
#define DUP_PHASE -1
#endif
#ifndef MK_N_LAUNCHES
#define MK_N_LAUNCHES 1
#endif

#define LAS __attribute__((address_space(3)))
#define GAS __attribute__((address_space(1)))
typedef unsigned short bf16_t;
typedef short bf16x8 __attribute__((ext_vector_type(8)));
typedef float f32x4 __attribute__((ext_vector_type(4)));
typedef float f32x2 __attribute__((ext_vector_type(2)));
typedef unsigned u32x4 __attribute__((ext_vector_type(4)));
typedef unsigned u32x2 __attribute__((ext_vector_type(2)));

constexpr int T = 32768, D = 1024, SEQ = 4096, NB = 8, NZ = 9216, NE = 32, MEMR = 2048  ;
constexpr float LN_EPS = 1e-5f, ALPHA = 1.189207115002721f, LOG2E = 1.4426950408889634f;
constexpr float QSCALE = 0.0625f * LOG2E;
constexpr int NWAVES = 8, NTHR = 512;

constexpr size_t MiB = 1u << 20;
constexpr size_t WS_CTL = 0, CTL_ZERO_BYTES = 128 * 1024;
constexpr size_t WS_WTRIL = 1 * MiB;
constexpr size_t WS_WRHI = 1 * MiB + 512 * 1024;
constexpr size_t WS_WRLO = WS_WRHI + 64 * 1024;
constexpr size_t WS_WIN = 2 * MiB;
constexpr size_t WS_WKV = 20 * MiB;
constexpr size_t WS_WP8 = 24 * MiB;
constexpr size_t WS_WOUT = 30 * MiB;
constexpr size_t WS_WGU = 32 * MiB;
constexpr size_t WS_WDN = 160 * MiB;
constexpr size_t WS_X8 = 224 * MiB;
constexpr size_t WS_WIN8 = 12 * MiB;
constexpr size_t WS_X1H = 224 * MiB;
constexpr size_t WS_EO = 288 * MiB;
constexpr size_t WS_XB = 288 * MiB;
constexpr size_t WS_SCR = 352 * MiB;
constexpr size_t WS_Z = 416 * MiB;
constexpr size_t ZSTRIDE = 64 * MiB;
constexpr size_t WS_MERGED = WS_Z + 1 * ZSTRIDE;
constexpr size_t WS_YB8 = WS_Z + 2 * ZSTRIDE;
constexpr size_t WS_X1B = WS_Z + 2 * ZSTRIDE + 32 * MiB;
constexpr size_t WS_ACT = WS_Z + 3 * ZSTRIDE;
constexpr size_t WS_MEMNB = 992 * MiB;
constexpr size_t WS_KMAT = 996 * MiB;
constexpr size_t WS_VT = 1000 * MiB;
constexpr size_t WS_PERM = 1004 * MiB;
constexpr size_t WS_SGATE = 1008 * MiB;
constexpr size_t WS_TOK = 1012 * MiB;
constexpr size_t WS_GSTAT = 1013 * MiB;
constexpr size_t WS_END = 1024 * MiB;
constexpr int CW_BAR = 4096;
constexpr int CW_CNT = 16384;

constexpr int RING_BYTES = 131072, EPI_OFF = 131072, EPI_BYTES = 8192, MISC_OFF = EPI_OFF + EPI_BYTES, LDS_BYTES = 147456;
constexpr int EPI_SLOT_OFF = MISC_OFF + 1024, EPI_SLOT_BYTES = 2048;

#define LDS_WAIT() asm volatile("s_waitcnt lgkmcnt(0)" ::: "memory")
#define VM_WAIT() asm volatile("s_waitcnt vmcnt(0)" ::: "memory")
#define RLX_AGENT __ATOMIC_RELAXED, __HIP_MEMORY_SCOPE_AGENT

typedef __bf16 bf16x2_t __attribute__((ext_vector_type(2)));
__device__ __forceinline__ unsigned cvt_pk_bf16(float lo, float hi) { const f32x2 v = {lo, hi}; return __builtin_bit_cast(unsigned, __builtin_convertvector(v, bf16x2_t)); }
constexpr float EO8_SCALE = 32.0f, EO8_INV = 1.0f / 32.0f;
constexpr float W8_SCALE = 64.0f, W8_INV = 1.0f / 64.0f;
__device__ __forceinline__ unsigned cvt4_fp8(float a, float b, float c, float d) { int w = 0; w = __builtin_amdgcn_cvt_pk_fp8_f32(a, b, w, false); w = __builtin_amdgcn_cvt_pk_fp8_f32(c, d, w, true); return (unsigned)w; }
__device__ __forceinline__ unsigned cvt4_u8(float a, float b, float c, float d) { unsigned w = 0; w = __builtin_amdgcn_cvt_pk_u8_f32(a, 0, w); w = __builtin_amdgcn_cvt_pk_u8_f32(b, 1, w); w = __builtin_amdgcn_cvt_pk_u8_f32(c, 2, w); w = __builtin_amdgcn_cvt_pk_u8_f32(d, 3, w); return w; }
__device__ __forceinline__ float ub0(unsigned w) { return (float)(w & 0xffu); }
__device__ __forceinline__ float ub1(unsigned w) { return (float)((w >> 8) & 0xffu); }
__device__ __forceinline__ float ub2(unsigned w) { return (float)((w >> 16) & 0xffu); }
__device__ __forceinline__ float ub3(unsigned w) { return (float)(w >> 24); }
__device__ __forceinline__ float bf_lo(unsigned w) { return __uint_as_float(w << 16); }
__device__ __forceinline__ float bf_hi(unsigned w) { return __uint_as_float(w & 0xffff0000u); }
__device__ __forceinline__ float fast_exp2(float x) { return __builtin_amdgcn_exp2f(x); }
__device__ __forceinline__ float fast_rcp(float x) { return __builtin_amdgcn_rcpf(x); }
__device__ __forceinline__ float sigmoidf_(float x) { return fast_rcp(1.0f + fast_exp2(-LOG2E * x)); }
__device__ __forceinline__ f32x4 exp2_4(f32x4 x) { f32x4 r; r.x = fast_exp2(x.x); r.y = fast_exp2(x.y); r.z = fast_exp2(x.z); r.w = fast_exp2(x.w); return r; }
__device__ __forceinline__ f32x4 rcp_4(f32x4 x) { f32x4 r; r.x = fast_rcp(x.x); r.y = fast_rcp(x.y); r.z = fast_rcp(x.z); r.w = fast_rcp(x.w); return r; }
__device__ __forceinline__ f32x4 sigmoid_4(f32x4 x) { return rcp_4(exp2_4(x * (-LOG2E)) + 1.0f); }
__device__ __forceinline__ f32x4 gelu_tanh_4(f32x4 x) { constexpr float kk = -2.0f * 0.7978845608028654f * LOG2E; const f32x4 u = x * (x * x * (0.044715f * kk) + kk); return x * rcp_4(exp2_4(u) + 1.0f); }
__device__ __forceinline__ float gelu_tanh(float x) {
    const float u = x * (1.0f + 0.044715f * x * x);
    return x * fast_rcp(1.0f + fast_exp2(-2.0f * 0.7978845608028654f * LOG2E * u));
}
__device__ __forceinline__ int lane_id() { return (int)__builtin_amdgcn_mbcnt_hi(~0u, __builtin_amdgcn_mbcnt_lo(~0u, 0u)); }
__device__ __forceinline__ float wave_sum(float v) {
#pragma unroll
    for (int o = 1; o < 64; o <<= 1) v += __shfl_xor(v, o);
    return v;
}

constexpr int CW = 64, CQ = 16, CB = 8;
namespace pg8 {
constexpr int BM = 256, BK = 64, HALF = 128, HTB = HALF * BK * 2, STAGE_BYTES = 8 * HTB, NXCD = 8, WGM = 8;
__host__ __device__ __forceinline__ int lds_byte(int r, int c) { const int st = (r >> 4) * 2 + (c >> 5), rr = r & 15, cc = c & 31, ob = rr * 64 + cc * 2; return st * 1024 + (ob ^ (((ob >> 9) & 1) << 5)); }
__host__ __device__ __forceinline__ void stage_rc(int b, int& R, int& C) { const int st = b / 1024, sb = b % 1024, swz = sb ^ (((sb >> 9) & 1) << 5); R = (st >> 1) * 16 + swz / 64; C = (st & 1) * 32 + (swz % 64) / 2; }
__host__ __device__ __forceinline__ int perm32(int rho) { const int n = rho >> 4, i = rho & 15; return 8 * (i >> 2) + 4 * n + (i & 3); }

__device__ __forceinline__ bool tile_order(long L, int nM, int nN, int& pm, int& pn) {
    const int nwg = nM * nN; if (L >= nwg) return false;
    int wgid = (int)L; { const int q = nwg / NXCD, r = nwg % NXCD, xcd = wgid % NXCD, off = wgid / NXCD; wgid = (xcd < r ? xcd * (q + 1) : r * (q + 1) + (xcd - r) * q) + off; }
    const int nig = WGM * nN, gid = wgid / nig, fm = gid * WGM, gsz = (nM - fm) < WGM ? (nM - fm) : WGM;
    pm = fm + ((wgid % nig) % gsz); pn = (wgid % nig) / gsz; return true;
}

typedef int v8i __attribute__((ext_vector_type(8)));
typedef int v4i __attribute__((ext_vector_type(4)));
template <int N> __device__ __forceinline__ void wait_vm() { asm volatile("s_waitcnt vmcnt(%0)" :: "n"(N) : "memory"); }
template <class Epi, class Sched, bool ALIGN_EPI, bool SP2, bool F8 = false>
__device__ __forceinline__ void gemm_phase(LAS unsigned char* lds, const int wid_in, const int K, const int lda, const int ldb, const Sched& S, const Epi& E) {
    int lane_ = lane_id(); asm volatile("" : "+v"(lane_));
    const int lane = lane_, wid = wid_in, tid = wid * 64 + lane, wr = wid >> 2, wc = wid & 3, fr = lane & 15, fq = lane >> 4;
    const int nt = K / BK;
    int RA[2], CA[2];
    unsigned voffA[2], voffB[2][2];
#pragma unroll
    for (int i = 0; i < 2; ++i) { int R, C; stage_rc(tid * 16 + i * 8192, R, C);
        RA[i] = R; CA[i] = C; voffA[i] = (unsigned)(R * lda + C) * 2u;
#pragma unroll
        for (int h = 0; h < 2; ++h) { const int Rb = Epi::PERM ? (CW * (R >> 5) + CQ * ((R >> 2) & 3) + CB * h + 4 * ((R >> 4) & 1) + (R & 3)) : (R + HALF * h);
            voffB[h][i] = (unsigned)(Rb * ldb + C) * 2u; } }
    const size_t kstep = (size_t)(BK * 2);
    const size_t hstepA = (size_t)HALF * lda * 2;
    const unsigned ldsw = (unsigned)wid * 1024u;
    const int aoff = lds_byte(wr * 64 + fr, fq * 8), boff = lds_byte(wc * 32 + fr, fq * 8);
    const int a8o0 = lds_byte(wr * 64 + fr, 16 * fq + 8 * (fq >> 1)), a8o1 = lds_byte(wr * 64 + fr, 16 * fq + 8 * (1 - (fq >> 1)));
    const int b8o0 = lds_byte(wc * 32 + fr, 16 * fq + 8 * (fq >> 1)), b8o1 = lds_byte(wc * 32 + fr, 16 * fq + 8 * (1 - (fq >> 1)));
#define PG8_SA(b, h) (((b) * 2 + (h)) * HTB)
#define PG8_SB(b, h) ((4 + (b) * 2 + (h)) * HTB)
#define PG8_STAGE(bufoff, gbase, voff) do { _Pragma("unroll") for (int _i = 0; _i < 2; ++_i) \
        __builtin_amdgcn_global_load_lds((const unsigned*)((const char*)(gbase) + (voff)[_i]), (LAS unsigned*)(lds + (bufoff) + ldsw + _i * 8192), 16, 0, 0); } while (0)
#define PG8_STAGE_A(b, h, kptr, NX) do { if constexpr (Sched::GATHER) { unsigned _g[2]; _g[0] = (NX) ? gN[h][0] : gC[h][0]; _g[1] = (NX) ? gN[h][1] : gC[h][1]; PG8_STAGE(PG8_SA(b, h), kptr, _g); } \
        else { PG8_STAGE(PG8_SA(b, h), (kptr) + (h) * hstepA, voffA); } } while (0)
#define PG8_LD8(p0, p1) __builtin_shufflevector(*(const LAS v4i*)(p0), *(const LAS v4i*)(p1), 0, 1, 2, 3, 4, 5, 6, 7)
#define PG8_LDA(dst, b, h) do { _Pragma("unroll") for (int m = 0; m < 4; ++m) { if constexpr (F8) { dst##8[m] = PG8_LD8(lds + PG8_SA(b, h) + a8o0 + m * 2048, lds + PG8_SA(b, h) + a8o1 + m * 2048); } \
        else { _Pragma("unroll") for (int k = 0; k < 2; ++k) dst[m][k] = *(const LAS bf16x8*)(lds + PG8_SA(b, h) + aoff + m * 2048 + k * 1024); } } } while (0)
#define PG8_LDB(dst, b, h) do { _Pragma("unroll") for (int n = 0; n < 2; ++n) { if constexpr (F8) { dst##8[n] = PG8_LD8(lds + PG8_SB(b, h) + b8o0 + n * 2048, lds + PG8_SB(b, h) + b8o1 + n * 2048); } \
        else { _Pragma("unroll") for (int k = 0; k < 2; ++k) dst[n][k] = *(const LAS bf16x8*)(lds + PG8_SB(b, h) + boff + n * 2048 + k * 1024); } } } while (0)
#define PG8_MMA(ai, bj, At, Bt) do { __builtin_amdgcn_s_setprio(1); _Pragma("unroll") for (int m = 0; m < 4; ++m) _Pragma("unroll") for (int n = 0; n < 2; ++n) { \
        if constexpr (F8) { asm volatile("v_mfma_scale_f32_16x16x128_f8f6f4 %0, %1, %2, %0, %3, %3 op_sel_hi:[0,0,0]" : "+v"(acc[ai][bj][m][n]) : "v"(Bt##8[n]), "v"(At##8[m]), "v"(f8scale)); } \
        else { _Pragma("unroll") for (int k = 0; k < 2; ++k) acc[ai][bj][m][n] = __builtin_amdgcn_mfma_f32_16x16x32_bf16(Bt[n][k], At[m][k], acc[ai][bj][m][n], 0, 0, 0); } } __builtin_amdgcn_s_setprio(0); } while (0)
#define PG8_WAIT_V(n) asm volatile("s_waitcnt vmcnt(" #n ")" ::: "memory")
#define PG8_WAIT_L(n) asm volatile("s_waitcnt lgkmcnt(" #n ")" ::: "memory")
#define PG8_BAR __builtin_amdgcn_s_barrier()
#define PG8_SCHED __builtin_amdgcn_sched_barrier(0)
    typename Sched::U cur, nxt; int ui = 0;
    if (!S.next(0, cur)) return;
    LAS unsigned char* eslot = lds + EPI_SLOT_OFF;
    if constexpr (Epi::PREF) { if (wid == 0) E.prefetch(cur, eslot, lane); }
    unsigned gC[2][2] = {{0u, 0u}, {0u, 0u}}, gN[2][2] = {{0u, 0u}, {0u, 0u}};
    if constexpr (Sched::GATHER) {
#pragma unroll
        for (int h = 0; h < 2; ++h)
#pragma unroll
            for (int i = 0; i < 2; ++i) gC[h][i] = (S.arow(cur, RA[i] + HALF * h) * (unsigned)lda + (unsigned)CA[i]) * 2u;
    }
    f32x4 acc[2][2][4][2];
#pragma unroll
    for (int a = 0; a < 2; ++a)
#pragma unroll
        for (int b = 0; b < 2; ++b)
#pragma unroll
            for (int m = 0; m < 4; ++m)
#pragma unroll
                for (int n = 0; n < 2; ++n) acc[a][b][m][n] = (f32x4){0.f, 0.f, 0.f, 0.f};
    int f8scale = 0x7f7f7f7f; asm volatile("" : "+v"(f8scale));
    bf16x8 At[F8 ? 1 : 4][2], B0[F8 ? 1 : 2][2], B1[F8 ? 1 : 2][2];
    v8i At8[F8 ? 4 : 1], B08[F8 ? 2 : 1], B18[F8 ? 2 : 1];
    const char* cA = S.baseA(cur); const char* cB = S.baseB(cur);
    if constexpr (SP2) {
        PG8_STAGE(PG8_SB(0, 0), cB, voffB[0]); PG8_STAGE(PG8_SB(0, 1), cB, voffB[1]); PG8_STAGE_A(0, 0, cA, false); PG8_STAGE_A(0, 1, cA, false);
        if (wr == 1) PG8_BAR;
        PG8_WAIT_V(2); PG8_BAR;
        PG8_STAGE(PG8_SB(1, 0), cB + kstep, voffB[0]); PG8_STAGE_A(1, 0, cA + kstep, false); PG8_STAGE(PG8_SB(1, 1), cB + kstep, voffB[1]);
        PG8_WAIT_V(6); PG8_BAR;
    } else {
        PG8_STAGE(PG8_SB(0, 0), cB, voffB[0]); PG8_STAGE_A(0, 0, cA, false); PG8_STAGE(PG8_SB(0, 1), cB, voffB[1]); PG8_STAGE_A(0, 1, cA, false);
        if (wr == 1) PG8_BAR;
        PG8_WAIT_V(4); PG8_BAR;
        PG8_STAGE(PG8_SB(1, 0), cB + kstep, voffB[0]); PG8_STAGE_A(1, 0, cA + kstep, false); PG8_STAGE(PG8_SB(1, 1), cB + kstep, voffB[1]);
        PG8_WAIT_V(6); PG8_BAR;
    }
    for (;;) {
        const bool has_next = S.next(ui + 1, nxt);
        const char* nA = has_next ? S.baseA(nxt) : cA; const char* nB = has_next ? S.baseB(nxt) : cB;
        LAS unsigned char* gslot = lds + EPI_SLOT_OFF + 2 * EPI_SLOT_BYTES + ((ui + 1) & 1) * 1024;
        if constexpr (Sched::GATHER) { if (has_next && wid == 1) S.rows_dma(nxt, gslot, lane); }
#pragma unroll 1
        for (int t = 0; t < nt; t += 2) {
            const bool last = (t == nt - 2), seam = (t == 0) && (ui > 0);
            if constexpr (Sched::GATHER) { if (last) {
#pragma unroll
                for (int h = 0; h < 2; ++h)
#pragma unroll
                    for (int i = 0; i < 2; ++i) { int tid2 = tid; asm volatile("" : "+v"(tid2)); int R2, C2; stage_rc(tid2 * 16 + i * 8192, R2, C2);
                        const int r_ = R2 + HALF * h; const unsigned tokr = (has_next && r_ < nxt.nv) ? *(const LAS unsigned*)(gslot + 4 * r_) : 0u;
                        gN[h][i] = has_next ? (tokr * (unsigned)lda + (unsigned)C2) * 2u : gC[h][i]; } } }
            const char* a1 = cA + (size_t)(t + 1) * kstep;
            const char* a2 = last ? nA : cA + (size_t)(t + 2) * kstep; const char* b2 = last ? nB : cB + (size_t)(t + 2) * kstep;
            const char* a3 = a2 + kstep; const char* b3 = b2 + kstep;
            if constexpr (SP2) {
            PG8_LDB(B0, 0, 0); PG8_LDB(B1, 0, 1); PG8_SCHED; PG8_LDA(At, 0, 0); if (!seam) PG8_STAGE_A(1, 1, a1, false);
            if (seam) wait_vm<8 + Epi::NST>(); else PG8_WAIT_V(8); PG8_WAIT_L(0); PG8_BAR; PG8_MMA(0, 0, At, B0); PG8_MMA(0, 1, At, B1); PG8_BAR; PG8_SCHED;
            PG8_LDA(At, 0, 1); PG8_STAGE(PG8_SB(0, 0), b2, voffB[0]); PG8_STAGE(PG8_SB(0, 1), b2, voffB[1]); PG8_STAGE_A(0, 0, a2, last);
            if (seam) wait_vm<8 + Epi::NST>(); else PG8_WAIT_V(8); PG8_WAIT_L(0); PG8_BAR; PG8_MMA(1, 0, At, B0); PG8_MMA(1, 1, At, B1); PG8_BAR; PG8_SCHED;
            PG8_LDB(B0, 1, 0); PG8_LDB(B1, 1, 1); PG8_SCHED; PG8_LDA(At, 1, 0); PG8_STAGE_A(0, 1, a2, last);
            if (seam) wait_vm<8 + Epi::NST>(); else PG8_WAIT_V(8); PG8_WAIT_L(0); PG8_BAR; PG8_MMA(0, 0, At, B0); PG8_MMA(0, 1, At, B1); PG8_BAR; PG8_SCHED;
            PG8_LDA(At, 1, 1); PG8_STAGE(PG8_SB(1, 0), b3, voffB[0]); PG8_STAGE(PG8_SB(1, 1), b3, voffB[1]); PG8_STAGE_A(1, 0, a3, last);
            PG8_WAIT_V(8); PG8_WAIT_L(0); PG8_BAR; PG8_MMA(1, 0, At, B0); PG8_MMA(1, 1, At, B1); PG8_BAR; PG8_SCHED;
            } else {
            PG8_LDB(B0, 0, 0); PG8_SCHED; PG8_LDA(At, 0, 0); if (!seam) PG8_STAGE_A(1, 1, a1, false);
            PG8_WAIT_L(8); PG8_BAR; PG8_WAIT_L(0); PG8_MMA(0, 0, At, B0); PG8_BAR; PG8_SCHED;
            PG8_LDB(B1, 0, 1); PG8_STAGE(PG8_SB(0, 0), b2, voffB[0]);
            PG8_BAR; PG8_WAIT_L(0); PG8_MMA(0, 1, At, B1); PG8_BAR;
            PG8_LDA(At, 0, 1); PG8_STAGE_A(0, 0, a2, last);
            PG8_BAR; PG8_WAIT_L(0); PG8_MMA(1, 0, At, B0); PG8_BAR; PG8_SCHED;
            PG8_STAGE(PG8_SB(0, 1), b2, voffB[1]);
            if (seam) wait_vm<6 + Epi::NST>(); else PG8_WAIT_V(6); PG8_BAR; PG8_MMA(1, 1, At, B1); PG8_BAR;
            PG8_LDB(B0, 1, 0); PG8_SCHED; PG8_LDA(At, 1, 0); PG8_STAGE_A(0, 1, a2, last);
            PG8_WAIT_L(8); PG8_BAR; PG8_WAIT_L(0); PG8_MMA(0, 0, At, B0); PG8_BAR; PG8_SCHED;
            PG8_LDB(B1, 1, 1); PG8_STAGE(PG8_SB(1, 0), b3, voffB[0]);
            PG8_BAR; PG8_WAIT_L(0); PG8_MMA(0, 1, At, B1); PG8_BAR;
            PG8_LDA(At, 1, 1); PG8_STAGE_A(1, 0, a3, last);
            PG8_BAR; PG8_WAIT_L(0); PG8_MMA(1, 0, At, B0); PG8_BAR; PG8_SCHED;
            PG8_STAGE(PG8_SB(1, 1), b3, voffB[1]);
            PG8_WAIT_V(6); PG8_BAR; PG8_MMA(1, 1, At, B1); PG8_BAR;
            }
        }
        if (has_next) { PG8_STAGE_A(1, 1, nA + kstep, true); }
        if constexpr (ALIGN_EPI) { if (wr == 0) PG8_BAR; }
        { int fr2 = lane & 15, fq2 = lane >> 4; asm volatile("" : "+v"(fr2), "+v"(fq2));
          if constexpr (Epi::PREF) E(acc, cur, wr, wc, fr2, fq2, (const LAS unsigned char*)(eslot + (ui & 1) * EPI_SLOT_BYTES)); else E(acc, cur, wr, wc, fr2, fq2); }
        if (!has_next) break;
        if constexpr (!Epi::CHAIN) {
#pragma unroll
        for (int a = 0; a < 2; ++a)
#pragma unroll
            for (int b = 0; b < 2; ++b)
#pragma unroll
                for (int m = 0; m < 4; ++m)
#pragma unroll
                    for (int n = 0; n < 2; ++n) acc[a][b][m][n] = (f32x4){0.f, 0.f, 0.f, 0.f}; }
        cur = nxt; cA = nA; cB = nB; ++ui;
        if constexpr (Epi::PREF) { if (wid == 0) E.prefetch(cur, eslot + (ui & 1) * EPI_SLOT_BYTES, lane); }
        if constexpr (Sched::GATHER) {
#pragma unroll
            for (int h = 0; h < 2; ++h)
#pragma unroll
                for (int i = 0; i < 2; ++i) gC[h][i] = gN[h][i];
        }
        if constexpr (ALIGN_EPI) { if (wr == 1) PG8_BAR; }
    }
    PG8_WAIT_V(0);
    if constexpr (!ALIGN_EPI) { if (wr == 0) PG8_BAR; }
    PG8_BAR;
#undef PG8_SA
#undef PG8_SB
#undef PG8_STAGE
#undef PG8_STAGE_A
#undef PG8_LDA
#undef PG8_LDB
#undef PG8_MMA
#undef PG8_LD8
#undef PG8_WAIT_V
#undef PG8_WAIT_L
#undef PG8_BAR
#undef PG8_SCHED
}
}

struct TileU { int pm, pn; };
struct SchedDense {
    typedef TileU U; static constexpr bool GATHER = false;
    const char* A; const char* B; int nM, nN, G, c; size_t rsA, rsB;
    int reps = 1;
    __device__ __forceinline__ bool next(int i, U& u) const { const int nc = (nM * nN - c + G - 1) / G; if (i >= reps * nc) return false; return pg8::tile_order((long)(i % nc) * G + c, nM, nN, u.pm, u.pn); }
    __device__ __forceinline__ const char* baseA(const U& u) const { return A + (size_t)u.pm * rsA; }
    __device__ __forceinline__ const char* baseB(const U& u) const { return B + (size_t)u.pn * rsB; }
};
struct KvU { int pm, pn, vt; };
struct SchedKV {
    typedef KvU U; static constexpr bool GATHER = false;
    const char* memnb; const char* wkv; int c;
    __device__ __forceinline__ bool next(int i, U& u) const { if (i != 0 || c >= 64) return false; const int k = c & 31; u.vt = c >> 5; if (u.vt) { u.pm = k >> 3; u.pn = k & 7; } else { u.pm = k >> 2; u.pn = k & 3; } return true; }
    __device__ __forceinline__ const char* baseA(const U& u) const { return u.vt ? wkv + (size_t)(1024 + 256 * u.pm) * 1024 : memnb + (size_t)(256 * u.pm) * 1024; }
    __device__ __forceinline__ const char* baseB(const U& u) const { return u.vt ? memnb + (size_t)(256 * u.pn) * 1024 : wkv + (size_t)(256 * u.pn) * 1024; }
};
struct SchedAttn {
    typedef TileU U; static constexpr bool GATHER = false;
    const char* QP; const char* Bm; int pass, G, c;
    __device__ __forceinline__ bool next(int i, U& u) const { const int L = i * G + c; if (L >= 512) return false; u.pm = L >> 2; u.pn = L & 3; return true; }
    __device__ __forceinline__ const char* baseA(const U& u) const { return QP + ((size_t)u.pm * 256 * 1024 + (size_t)u.pn * 256); }
    __device__ __forceinline__ const char* baseB(const U& u) const { const int b = u.pm >> 4; return pass == 0 ? Bm + ((size_t)b * 256 * 1024 + (size_t)u.pn * 256) : Bm + ((size_t)u.pn * 256 * 2048 + (size_t)b * 256); }
};
struct MrgU { int pm, pn, br, j; };
struct SchedMerge {
    typedef MrgU U; static constexpr bool GATHER = false;
    const char* Y; const char* X; const char* W; int G, c;
    int reps = 1;
    __device__ __forceinline__ bool next(int i, U& u) const { const int nc = 3 * ((512 - c + G - 1) / G); if (i >= reps * nc) return false; const int ie = i % nc; const int j = ie / 3; u.j = j; u.br = ie - 3 * j; return pg8::tile_order((long)j * G + c, 128, 4, u.pm, u.pn); }
    __device__ __forceinline__ const char* baseA(const U& u) const { return (u.br == 2 ? X : Y + (size_t)u.br * (32 * MiB)) + (size_t)u.pm * 256 * 1024; }
    __device__ __forceinline__ const char* baseB(const U& u) const { return W + (size_t)u.br * MiB + (size_t)u.pn * 256 * 1024; }
};
struct MoeU { int pm, pn, e, nv; };
template <bool GATH> struct SchedMoe {
    typedef MoeU U; static constexpr bool GATHER = GATH;
    const char* A; const char* W; const int* perm; const LAS int* pref; const LAS int* cnt; int nN, G, c; size_t wstride; size_t tstep; int reps = 1;
    __device__ __forceinline__ bool next(int i, U& u) const {
        const int NT = pref[32]; const int nc = (NT * nN - c + G - 1) / G; if (i >= reps * nc) return false;
        if (!pg8::tile_order((long)(i % nc) * G + c, NT, nN, u.pm, u.pn)) return false;
        int e = -1;
        typedef int i32x4 __attribute__((ext_vector_type(4)));
        i32x4 pv[8];
#pragma unroll
        for (int j = 0; j < 8; ++j) pv[j] = ((const LAS i32x4*)pref)[j];
#pragma unroll
        for (int j = 0; j < 8; ++j) e += ((u.pm >= pv[j].x) ? 1 : 0) + ((u.pm >= pv[j].y) ? 1 : 0) + ((u.pm >= pv[j].z) ? 1 : 0) + ((u.pm >= pv[j].w) ? 1 : 0);
        u.e = __builtin_amdgcn_readfirstlane(e); const int r0 = (u.pm - pref[u.e]) * 256; int nv = cnt[u.e] - r0; u.nv = nv > 256 ? 256 : nv; return true;
    }
    __device__ __forceinline__ const char* baseA(const U& u) const { return GATH ? A : A + (size_t)u.pm * tstep; }
    __device__ __forceinline__ const char* baseB(const U& u) const { return W + (size_t)u.e * wstride + (size_t)u.pn * tstep; }
    __device__ __forceinline__ void rows_dma(const U& u, LAS unsigned char* dst, int lane) const {
        const int* src = perm + (size_t)u.e * 32768 + (size_t)(u.pm - pref[u.e]) * 256 + lane * 4;
        __builtin_amdgcn_global_load_lds((const unsigned*)src, (LAS unsigned*)dst, 16, 0, 0); }
    __device__ __forceinline__ unsigned arow(const U& u, int r) const { return (r < u.nv) ? (unsigned)perm[(size_t)u.e * 32768 + (size_t)(u.pm - pref[u.e]) * 256 + r] : 0u; }
};

struct EpiZ {
    static constexpr bool PERM = true; static constexpr bool PREF = true; static constexpr int NST = 8; static constexpr bool CHAIN = false;
    __device__ __forceinline__ void prefetch(const TileU& u, LAS unsigned char* slot, int lane) const {
        const int pn = u.pn + pn_off, grp = pn >> 2; if (grp < 6) return;
        __builtin_amdgcn_global_load_lds((const unsigned*)(b_gate + (grp - 6) * 1024 + (pn & 3) * 256 + lane * 4), (LAS unsigned*)slot, 16, 0, 0); }
    bf16_t* Z; const float* b_gate; int pn_off; float ascale; f32x2* gstat = nullptr;
    template <int MODE> __device__ __forceinline__ void run(const f32x4 (&acc)[2][2][4][2], bf16_t* base, const LAS float* bias, int row0, int col0, f32x2* stat = nullptr, int fq = 0) const {
        f32x4 bv[2][2];
#pragma unroll
        for (int bj = 0; bj < 2; ++bj)
#pragma unroll
            for (int n = 0; n < 2; ++n) bv[bj][n] = (MODE == 2) ? *(const LAS f32x4*)(bias + (col0 & 255) + bj * CB + 4 * n) * (-LOG2E) : (f32x4){0.f, 0.f, 0.f, 0.f};
#pragma unroll
        for (int ai = 0; ai < 2; ++ai)
#pragma unroll
            for (int m = 0; m < 4; ++m) { bf16_t* rowp = base + (size_t)(row0 + ai * 128 + m * 16) * D + col0; float s1 = 0.f, s2 = 0.f;
#pragma unroll
                for (int bj = 0; bj < 2; ++bj) { f32x4 v0 = acc[ai][bj][m][0], v1 = acc[ai][bj][m][1];
                    if (MODE == 1) {
#pragma unroll
                        for (int j = 0; j < 1; ++j) { v0 = gelu_tanh_4(v0); v1 = gelu_tanh_4(v1); }
                        if (stat) {
#pragma unroll
                            for (int j = 0; j < 4; ++j) { s1 += v0[j] + v1[j]; s2 += v0[j] * v0[j] + v1[j] * v1[j]; } } }
                    if (MODE == 2) { v0 = exp2_4(v0 * (-LOG2E * ascale) + bv[bj][0]); v1 = exp2_4(v1 * (-LOG2E * ascale) + bv[bj][1]);
                        v0 = rcp_4(v0 * (1.f / 255.f) + (1.f / 255.f)); v1 = rcp_4(v1 * (1.f / 255.f) + (1.f / 255.f));
#pragma unroll
                        for (int j = 0; j < 4; ++j) { v0[j] = fmaxf(v0[j], 1.0f); v1[j] = fmaxf(v1[j], 1.0f); }
                        u32x2 w8; w8.x = cvt4_u8(v0[0], v0[1], v0[2], v0[3]); w8.y = cvt4_u8(v1[0], v1[1], v1[2], v1[3]);
                        *(u32x2*)((unsigned char*)base + (size_t)(row0 + ai * 128 + m * 16) * D + col0 + bj * CB) = w8; continue; }
                    if (MODE == 3) { v0 *= ascale; v1 *= ascale; u32x2 w8; w8.x = cvt4_fp8(v0[0], v0[1], v0[2], v0[3]); w8.y = cvt4_fp8(v1[0], v1[1], v1[2], v1[3]);
                        *(u32x2*)((unsigned char*)base + (size_t)(row0 + ai * 128 + m * 16) * D + col0 + bj * CB) = w8; continue; }
                    u32x4 w; w.x = cvt_pk_bf16(v0[0], v0[1]); w.y = cvt_pk_bf16(v0[2], v0[3]); w.z = cvt_pk_bf16(v1[0], v1[1]); w.w = cvt_pk_bf16(v1[2], v1[3]);
                    *(u32x4*)(rowp + bj * CB) = w; }
                if (MODE == 1) { if (stat) { s1 += __shfl_xor(s1, 16); s1 += __shfl_xor(s1, 32); s2 += __shfl_xor(s2, 16); s2 += __shfl_xor(s2, 32);
                    if (fq == 0) stat[(size_t)(row0 + ai * 128 + m * 16) * 16] = (f32x2){s1, s2}; } } }
    }
    __device__ __forceinline__ void operator()(const f32x4 (&acc)[2][2][4][2], const TileU& u, int wr, int wc, int fr, int fq, const LAS unsigned char* slot) const {
        const int pn = u.pn + pn_off; const int grp = pn >> 2, colt = (pn & 3) * 256;
        const int row0 = u.pm * 256 + wr * 64 + fr;
        if (pn < 20) {
            if (pn >= 4 && pn < 12) {
                bf16_t* pb = Z + (size_t)1 * (ZSTRIDE / 2); const int j0 = (pn - 4) * 128 + wc * 32 + 8 * fq;
#pragma unroll
                for (int ai = 0; ai < 2; ++ai)
#pragma unroll
                    for (int m = 0; m < 4; ++m) { const f32x4 p0 = acc[ai][0][m][0] * acc[ai][1][m][0], p1 = acc[ai][0][m][1] * acc[ai][1][m][1];
                        u32x4 w; w.x = cvt_pk_bf16(p0[0], p0[1]); w.y = cvt_pk_bf16(p0[2], p0[3]); w.z = cvt_pk_bf16(p1[0], p1[1]); w.w = cvt_pk_bf16(p1[2], p1[3]);
                        *(u32x4*)(pb + (size_t)(row0 + ai * 128 + m * 16) * D + j0) = w; }
                return; }
            const int g2 = (pn < 4) ? 0 : (pn < 16 ? 3 : 4), c2 = ((pn < 4) ? pn : (pn < 16 ? pn - 12 : pn - 16)) * 256 + wc * CW + fq * CQ;
            bf16_t* b2 = Z + (size_t)g2 * (ZSTRIDE / 2);
            if (pn < 4) run<0>(acc, b2, nullptr, row0, c2);
            else if (pn < 16) run<1>(acc, b2, nullptr, row0, c2);
            else run<1>(acc, b2, nullptr, row0, c2, gstat + (pn - 16) * 4 + wc, fq);
            return; }
        bf16_t* base = Z + (size_t)grp * (ZSTRIDE / 2);
        const int col0 = colt + wc * CW + fq * CQ;
        if (grp == 5) run<3>(acc, base, nullptr, row0, col0);
        else run<2>(acc, base, (const LAS float*)slot, row0, col0);
    }
};
__device__ __forceinline__ void store_bf16_tile(const f32x4 (&acc)[2][2][4][2], bf16_t* O, size_t ldc, int row0, int col0) {
#pragma unroll
    for (int ai = 0; ai < 2; ++ai)
#pragma unroll
        for (int m = 0; m < 4; ++m) { bf16_t* rowp = O + (size_t)(row0 + ai * 128 + m * 16) * ldc + col0;
#pragma unroll
            for (int bj = 0; bj < 2; ++bj) { const f32x4 v0 = acc[ai][bj][m][0], v1 = acc[ai][bj][m][1];
                u32x4 w; w.x = cvt_pk_bf16(v0[0], v0[1]); w.y = cvt_pk_bf16(v0[2], v0[3]); w.z = cvt_pk_bf16(v1[0], v1[1]); w.w = cvt_pk_bf16(v1[2], v1[3]);
                *(u32x4*)(rowp + bj * CB) = w; } }
}
__device__ __forceinline__ void store_fp8_tile(const f32x4 (&acc)[2][2][4][2], unsigned char* O, size_t ldc, int row0, int col0, float scale) {
#pragma unroll
    for (int ai = 0; ai < 2; ++ai)
#pragma unroll
        for (int m = 0; m < 4; ++m) { unsigned char* rowp = O + (size_t)(row0 + ai * 128 + m * 16) * ldc + col0;
#pragma unroll
            for (int bj = 0; bj < 2; ++bj) { const f32x4 v0 = acc[ai][bj][m][0] * scale, v1 = acc[ai][bj][m][1] * scale;
                u32x2 w; w.x = cvt4_fp8(v0[0], v0[1], v0[2], v0[3]); w.y = cvt4_fp8(v1[0], v1[1], v1[2], v1[3]); *(u32x2*)(rowp + bj * CB) = w; } }
}
struct EpiKV {
    static constexpr bool PERM = true; static constexpr bool PREF = false; static constexpr int NST = 8; static constexpr bool CHAIN = false;
    unsigned char* Kmat; unsigned char* Vt;
    __device__ __forceinline__ void operator()(const f32x4 (&acc)[2][2][4][2], const KvU& u, int wr, int wc, int fr, int fq) const {
        const int row0 = u.pm * 256 + wr * 64 + fr, col0 = u.pn * 256 + wc * CW + fq * CQ;
        if (u.vt) store_fp8_tile(acc, Vt, 2048, row0, col0, W8_INV); else store_fp8_tile(acc, Kmat, 1024, row0, col0, W8_INV);
    }
};
struct EpiAttnS {
    static constexpr bool PERM = true; static constexpr bool PREF = false; static constexpr int NST = 8; static constexpr bool CHAIN = false;
    unsigned char* QP; LAS float* red;
    __device__ __forceinline__ void operator()(f32x4 (&acc)[2][2][4][2], const TileU& u, int wr, int wc, int fr, int fq) const {
        LAS float* rmax = red; LAS float* rsum = red + 1024;
#pragma unroll
        for (int ai = 0; ai < 2; ++ai)
#pragma unroll
            for (int bj = 0; bj < 2; ++bj)
#pragma unroll
                for (int m = 0; m < 4; ++m)
#pragma unroll
                    for (int n = 0; n < 2; ++n) acc[ai][bj][m][n] *= QSCALE;
#pragma unroll
        for (int ai = 0; ai < 2; ++ai)
#pragma unroll
            for (int m = 0; m < 4; ++m) { float mx = -3.0e38f;
#pragma unroll
                for (int bj = 0; bj < 2; ++bj)
#pragma unroll
                    for (int n = 0; n < 2; ++n) { const f32x4 x = acc[ai][bj][m][n]; mx = fmaxf(mx, fmaxf(fmaxf(x[0], x[1]), fmaxf(x[2], x[3]))); }
                mx = fmaxf(mx, __shfl_xor(mx, 16)); mx = fmaxf(mx, __shfl_xor(mx, 32));
                if (fq == 0) rmax[(ai * 128 + wr * 64 + m * 16 + fr) * 4 + wc] = mx; }
        asm volatile("s_waitcnt lgkmcnt(0)" ::: "memory"); __builtin_amdgcn_s_barrier(); asm volatile("" ::: "memory");
#pragma unroll
        for (int ai = 0; ai < 2; ++ai)
#pragma unroll
            for (int m = 0; m < 4; ++m) { const int r = ai * 128 + wr * 64 + m * 16 + fr; const f32x4 q = *(const LAS f32x4*)(rmax + r * 4);
                const float mx = fmaxf(fmaxf(q[0], q[1]), fmaxf(q[2], q[3])); float s = 0.f;
#pragma unroll
                for (int bj = 0; bj < 2; ++bj)
#pragma unroll
                    for (int n = 0; n < 2; ++n) { f32x4 x = acc[ai][bj][m][n];
#pragma unroll
                        for (int j = 0; j < 4; ++j) { x[j] = fast_exp2(x[j] - mx); s += x[j]; }
                        acc[ai][bj][m][n] = x; }
                s += __shfl_xor(s, 16); s += __shfl_xor(s, 32);
                if (fq == 0) rsum[r * 4 + wc] = s; }
        asm volatile("s_waitcnt lgkmcnt(0)" ::: "memory"); __builtin_amdgcn_s_barrier(); asm volatile("" ::: "memory");
        const int row0 = u.pm * 256 + wr * 64 + fr, col0 = u.pn * 256 + wc * CW + fq * CQ;
#pragma unroll
        for (int ai = 0; ai < 2; ++ai)
#pragma unroll
            for (int m = 0; m < 4; ++m) { const int r = ai * 128 + wr * 64 + m * 16 + fr; const f32x4 q = *(const LAS f32x4*)(rsum + r * 4);
                const float inv = 256.0f * fast_rcp((q[0] + q[1]) + (q[2] + q[3]));
                unsigned char* rowp = QP + (size_t)(row0 + ai * 128 + m * 16) * D + col0;
#pragma unroll
                for (int bj = 0; bj < 2; ++bj) { const f32x4 v0 = acc[ai][bj][m][0] * inv, v1 = acc[ai][bj][m][1] * inv;
                    u32x2 w; w.x = cvt4_fp8(v0[0], v0[1], v0[2], v0[3]); w.y = cvt4_fp8(v1[0], v1[1], v1[2], v1[3]);
                    *(u32x2*)(rowp + bj * CB) = w; } }
        asm volatile("s_waitcnt lgkmcnt(0)" ::: "memory"); __builtin_amdgcn_s_barrier(); asm volatile("" ::: "memory");
    }
};
struct EpiAttnO {
    static constexpr bool PERM = true; static constexpr bool PREF = false; static constexpr int NST = 8; static constexpr bool CHAIN = false;
    unsigned char* Y8;
    __device__ __forceinline__ void operator()(const f32x4 (&acc)[2][2][4][2], const TileU& u, int wr, int wc, int fr, int fq) const {
        const int row0 = u.pm * 256 + wr * 64 + fr, col0 = u.pn * 256 + wc * CW + fq * CQ;
#pragma unroll
        for (int ai = 0; ai < 2; ++ai)
#pragma unroll
            for (int m = 0; m < 4; ++m) { unsigned char* rowp = Y8 + (size_t)(row0 + ai * 128 + m * 16) * D + col0;
#pragma unroll
                for (int bj = 0; bj < 2; ++bj) { const f32x4 v0 = acc[ai][bj][m][0] * (1.0f / 256.0f), v1 = acc[ai][bj][m][1] * (1.0f / 256.0f);
                    u32x2 w; w.x = cvt4_fp8(v0[0], v0[1], v0[2], v0[3]); w.y = cvt4_fp8(v1[0], v1[1], v1[2], v1[3]); *(u32x2*)(rowp + bj * CB) = w; } }
    }
};
struct EpiMerge {
    static constexpr bool PERM = true; static constexpr bool PREF = false; static constexpr int NST = 8; static constexpr bool CHAIN = true;
    const bf16_t* Z; bf16_t* merged;
    __device__ __forceinline__ bool keep(const MrgU& u) const { return u.br != 2; }
    __device__ __forceinline__ void operator()(f32x4 (&acc)[2][2][4][2], const MrgU& u, int wr, int wc, int fr, int fq) const {
        const int row0 = u.pm * 256 + wr * 64 + fr, col0 = u.pn * 256 + wc * CW + fq * CQ;
        const bool lastb = u.br == 2;
        GAS const unsigned char* gp = (GAS const unsigned char*)Z + (size_t)(6 + u.br) * ZSTRIDE + (size_t)row0 * D + col0;
        GAS const unsigned char* hp = lastb ? gp : gp + ZSTRIDE;
        GAS bf16_t* mp = (GAS bf16_t*)merged + (size_t)row0 * D + col0;
        asm volatile("" : "+v"(gp), "+v"(hp), "+v"(mp));
        const float fin = W8_INV * (1.f / 255.f), keepf = lastb ? 0.f : 1.f;
        u32x4 gq[2][2], hq[2][2];
#define MRG_LOAD(buf_) do { gq[buf_][0] = *(GAS const u32x4*)gp; hq[buf_][0] = *(GAS const u32x4*)hp; gq[buf_][1] = *(GAS const u32x4*)(gp + 16 * D); hq[buf_][1] = *(GAS const u32x4*)(hp + 16 * D); } while (0)
        MRG_LOAD(0); gp += 32 * D; hp += 32 * D; asm volatile("" : "+v"(gp), "+v"(hp));
#pragma unroll
        for (int b = 0; b < 4; ++b) { const int ai = b >> 1, buf = b & 1;
            if (b < 3) { MRG_LOAD((b + 1) & 1); gp += (b == 0 ? 96 : 32) * D; hp += (b == 0 ? 96 : 32) * D; asm volatile("" : "+v"(gp), "+v"(hp)); }
#pragma unroll
            for (int r = 0; r < 2; ++r) { const int m = 2 * (b & 1) + r;
#pragma unroll
                for (int bj = 0; bj < 2; ++bj) { const unsigned gx = bj ? gq[buf][r].z : gq[buf][r].x, gy = bj ? gq[buf][r].w : gq[buf][r].y;
                    const unsigned hx = bj ? hq[buf][r].z : hq[buf][r].x, hy = bj ? hq[buf][r].w : hq[buf][r].y;
                    f32x4 s0 = {ub0(gx), ub1(gx), ub2(gx), ub3(gx)}, s1 = {ub0(gy), ub1(gy), ub2(gy), ub3(gy)};
                    if (lastb) { const f32x4 v0 = acc[ai][bj][m][0] * (s0 * fin), v1 = acc[ai][bj][m][1] * (s1 * fin);
                        u32x4 w; w.x = cvt_pk_bf16(v0[0], v0[1]); w.y = cvt_pk_bf16(v0[2], v0[3]); w.z = cvt_pk_bf16(v1[0], v1[1]); w.w = cvt_pk_bf16(v1[2], v1[3]);
                        *(GAS u32x4*)(mp + bj * CB) = w;
                        acc[ai][bj][m][0] *= keepf; acc[ai][bj][m][1] *= keepf; }
                    else { acc[ai][bj][m][0] *= s0 * rcp_4((f32x4){ub0(hx), ub1(hx), ub2(hx), ub3(hx)}); acc[ai][bj][m][1] *= s1 * rcp_4((f32x4){ub0(hy), ub1(hy), ub2(hy), ub3(hy)}); }
                    asm volatile("" : "+v"(acc[ai][bj][m][0]), "+v"(acc[ai][bj][m][1])); }
                mp += (size_t)((b == 1 && r == 1) ? 80 : 16) * D; asm volatile("" : "+v"(mp)); }
            asm volatile("" ::: "memory"); }
#undef MRG_LOAD
    }
};
struct EpiResid {
    static constexpr bool PERM = true; static constexpr bool PREF = false; static constexpr int NST = 8; static constexpr bool CHAIN = false;
    const bf16_t* x; bf16_t* out;
    __device__ __forceinline__ void operator()(const f32x4 (&acc)[2][2][4][2], const TileU& u, int wr, int wc, int fr, int fq) const {
        const int row0 = u.pm * 256 + wr * 64 + fr, col0 = u.pn * 256 + wc * CW + fq * CQ;
        GAS const bf16_t* xp = (GAS const bf16_t*)x + (size_t)row0 * D + col0; GAS bf16_t* op = (GAS bf16_t*)out + (size_t)row0 * D + col0;
        asm volatile("" : "+v"(xp), "+v"(op));
        u32x4 xq[2][4];
#define RES_LOAD(buf_) do { xq[buf_][0] = *(GAS const u32x4*)xp; xq[buf_][1] = *(GAS const u32x4*)(xp + CB); xq[buf_][2] = *(GAS const u32x4*)(xp + 16 * D); xq[buf_][3] = *(GAS const u32x4*)(xp + 16 * D + CB); } while (0)
        RES_LOAD(0); xp += 32 * D; asm volatile("" : "+v"(xp));
#pragma unroll
        for (int b = 0; b < 4; ++b) { const int ai = b >> 1, buf = b & 1;
            if (b < 3) { RES_LOAD((b + 1) & 1); xp += (b == 0 ? 96 : 32) * D; asm volatile("" : "+v"(xp)); }
#pragma unroll
            for (int r = 0; r < 2; ++r) { const int m = 2 * (b & 1) + r;
#pragma unroll
                for (int bj = 0; bj < 2; ++bj) { const u32x4 q = xq[buf][r * 2 + bj];
                    const f32x4 x0 = {bf_lo(q.x), bf_hi(q.x), bf_lo(q.y), bf_hi(q.y)}, x1 = {bf_lo(q.z), bf_hi(q.z), bf_lo(q.w), bf_hi(q.w)};
                    const f32x4 v0 = x0 * ALPHA + acc[ai][bj][m][0], v1 = x1 * ALPHA + acc[ai][bj][m][1];
                    u32x4 w; w.x = cvt_pk_bf16(v0[0], v0[1]); w.y = cvt_pk_bf16(v0[2], v0[3]); w.z = cvt_pk_bf16(v1[0], v1[1]); w.w = cvt_pk_bf16(v1[2], v1[3]);
                    *(GAS u32x4*)(op + bj * CB) = w; }
                op += (size_t)((b == 1 && r == 1) ? 80 : 16) * D; asm volatile("" : "+v"(op)); }
            asm volatile("" ::: "memory"); }
#undef RES_LOAD
    }
};
struct EpiAct {
    static constexpr bool PERM = true; static constexpr bool PREF = true; static constexpr int NST = 8; static constexpr bool CHAIN = false;
    __device__ __forceinline__ void prefetch(const MoeU& u, LAS unsigned char* slot, int lane) const {
        const float* src = bgu + (size_t)u.e * 2048 + u.pn * 128 + ((lane < 32) ? lane * 4 : 1024 + (lane - 32) * 4);
        __builtin_amdgcn_global_load_lds((const unsigned*)src, (LAS unsigned*)slot, 16, 0, 0); }
    unsigned char* act; const float* bgu;
    __device__ __forceinline__ void operator()(const f32x4 (&acc)[2][2][4][2], const MoeU& u, int wr, int wc, int fr, int fq, const LAS unsigned char* slot) const {
        const int row0 = u.pm * 256 + wr * 64 + fr, jl = wc * 32 + 8 * fq, j0 = u.pn * 128 + jl;
        const LAS float* bg = (const LAS float*)slot + jl; const LAS float* bu = bg + 128;
        f32x4 bgv[2], buv[2];
#pragma unroll
        for (int n = 0; n < 2; ++n) { bgv[n] = *(const LAS f32x4*)(bg + 4 * n); buv[n] = *(const LAS f32x4*)(bu + 4 * n) + 1.0f; }
#pragma unroll
        for (int ai = 0; ai < 2; ++ai)
#pragma unroll
            for (int m = 0; m < 4; ++m) { f32x4 o[2];
#pragma unroll
                for (int n = 0; n < 2; ++n) { const f32x4 g = acc[ai][0][m][n] * W8_INV + bgv[n], uu = acc[ai][1][m][n] * W8_INV + buv[n];
                    f32x4 gl, ul;
#pragma unroll
                    for (int j = 0; j < 4; ++j) { gl[j] = fminf(g[j], 7.0f); ul[j] = fminf(fmaxf(uu[j], -6.0f), 8.0f); }
                    o[n] = ul * (gl * rcp_4(exp2_4(gl * (-1.702f * LOG2E)) + 1.0f)); }
                u32x2 w; w.x = cvt4_fp8(o[0][0], o[0][1], o[0][2], o[0][3]); w.y = cvt4_fp8(o[1][0], o[1][1], o[1][2], o[1][3]);
                *(u32x2*)(act + (size_t)(row0 + ai * 128 + m * 16) * D + j0) = w; }
    }
};
struct EpiDown {
    static constexpr bool PERM = true; static constexpr bool PREF = true; static constexpr int NST = 8; static constexpr bool CHAIN = false;
    __device__ __forceinline__ void prefetch(const MoeU& u, LAS unsigned char* slot, int lane) const {
        __builtin_amdgcn_global_load_lds((const unsigned*)(bdn + (size_t)u.e * 1024 + u.pn * 256 + lane * 4), (LAS unsigned*)slot, 16, 0, 0); }
    unsigned char* eo; const float* bdn; const float* sgate; const LAS int* pref;
    __device__ __forceinline__ void operator()(const f32x4 (&acc)[2][2][4][2], const MoeU& u, int wr, int wc, int fr, int fq, const LAS unsigned char* slot) const {
        const int rl0 = wr * 64 + fr, row0 = u.pm * 256 + rl0, cl = wc * CW + fq * CQ, col0 = u.pn * 256 + cl;
        const LAS float* bd = (const LAS float*)slot + cl;
        f32x4 bv[2][2];
#pragma unroll
        for (int bj = 0; bj < 2; ++bj)
#pragma unroll
            for (int n = 0; n < 2; ++n) bv[bj][n] = *(const LAS f32x4*)(bd + bj * CB + 4 * n) * EO8_SCALE;
#pragma unroll
        for (int ai = 0; ai < 2; ++ai)
#pragma unroll
            for (int m = 0; m < 4; ++m) { unsigned char* rowp = eo + (size_t)(row0 + ai * 128 + m * 16) * D + col0;
#pragma unroll
                for (int bj = 0; bj < 2; ++bj) { const f32x4 v0 = acc[ai][bj][m][0] * (W8_INV * EO8_SCALE) + bv[bj][0], v1 = acc[ai][bj][m][1] * (W8_INV * EO8_SCALE) + bv[bj][1];
                    u32x2 w; w.x = cvt4_fp8(v0[0], v0[1], v0[2], v0[3]); w.y = cvt4_fp8(v1[0], v1[1], v1[2], v1[3]);
                    *(u32x2*)(rowp + bj * CB) = w; } }
    }
};

#define XB_TMO      128
#define XB_XCNT(j)  (256  + 64 * (j))
#define XB_XSUB(j)  (1280 + 64 * (j))
#define XB_XGEN(j)  (2304 + 64 * (j))
#define XB_TOP      3328
#define XB_TOPGEN   3392
#define XCD_BAR_WORDS 3456
#define XB_SPIN_CAP (1u << 20)
__device__ __forceinline__ unsigned xb_ld(unsigned* p)              { return __hip_atomic_load(p, __ATOMIC_RELAXED, __HIP_MEMORY_SCOPE_AGENT); }
__device__ __forceinline__ unsigned xb_add(unsigned* p, unsigned v) { return __hip_atomic_fetch_add(p, v, __ATOMIC_RELAXED, __HIP_MEMORY_SCOPE_AGENT); }
__device__ __forceinline__ unsigned xb_xcc_id() { return (unsigned)__builtin_amdgcn_s_getreg((3 << 11) | 20) & 0xFu; }
#define XB_SPIN(cond, bar) do { unsigned _sp = 0; while (cond) { __builtin_amdgcn_s_sleep(1); \
    if ((++_sp & 255u) == 0u) { if (xb_ld(&(bar)[XB_TMO])) break; if (_sp > XB_SPIN_CAP) { atomicAdd(&(bar)[XB_TMO], 1u); break; } } } } while (0)
struct XcdBarrier { unsigned* bar; unsigned x; volatile LAS unsigned* st; };
__device__ __forceinline__ XcdBarrier xcd_barrier_post(unsigned* bar, volatile LAS unsigned* st) {
    XcdBarrier b; b.bar = bar; b.x = xb_xcc_id(); b.st = st;
    if (threadIdx.x == 0) (void)xb_add(&bar[XB_XCNT(b.x)], 1u);
    return b;
}
__device__ __forceinline__ void xcd_barrier_complete(unsigned* bar, unsigned x, unsigned& nloc, unsigned& nx) {
    const unsigned G = gridDim.x * gridDim.y * gridDim.z;
    unsigned sum, cnt, mine, sp = 0u;
    for (;;) {
        sum = 0u; cnt = 0u; mine = 0u;
#pragma unroll
        for (unsigned j = 0; j < 16; ++j) { const unsigned c = xb_ld(&bar[XB_XCNT(j)]); sum += c; cnt += (c > 0u) ? 1u : 0u; mine = (j == x) ? c : mine; }
        if (sum == G) break;
        __builtin_amdgcn_s_sleep(1);
        if ((++sp & 255u) == 0u) { if (xb_ld(&bar[XB_TMO])) break; if (sp > XB_SPIN_CAP) { atomicAdd(&bar[XB_TMO], 1u); break; } }
    }
    nloc = mine > 0u ? mine : 1u; nx = cnt > 0u ? cnt : 1u;
}
__device__ __forceinline__ void xcd_barrier(const XcdBarrier& b) {
    asm volatile("s_waitcnt vmcnt(0)" ::: "memory");
    __syncthreads();
    if (threadIdx.x == 0) {
        unsigned* bar = b.bar;
        __builtin_amdgcn_s_waitcnt(0);
        unsigned nloc = b.st[0], nx = b.st[1];
        if (nloc == 0u) { xcd_barrier_complete(bar, b.x, nloc, nx); b.st[0] = nloc; b.st[1] = nx; }
        const unsigned old = xb_add(&bar[XB_XSUB(b.x)], 1u);
        const unsigned gen = old / nloc;
        if (old + 1u == (gen + 1u) * nloc) {
            __builtin_amdgcn_fence(__ATOMIC_RELEASE, "agent");
            asm volatile("s_waitcnt vmcnt(0)" ::: "memory");
            const unsigned og = xb_add(&bar[XB_TOP], 1u);
            const unsigned tg = og / nx;
            if (og + 1u == (tg + 1u) * nx) xb_add(&bar[XB_TOPGEN], 1u);
            else XB_SPIN(xb_ld(&bar[XB_TOPGEN]) == tg, bar);
            __builtin_amdgcn_fence(__ATOMIC_ACQUIRE, "agent");
            xb_add(&bar[XB_XGEN(b.x)], 1u);
            asm volatile("s_waitcnt vmcnt(0)" ::: "memory");
        } else {
            XB_SPIN(xb_ld(&bar[XB_XGEN(b.x)]) == gen, bar);
            __builtin_amdgcn_fence(__ATOMIC_ACQUIRE, "agent");
            asm volatile("s_waitcnt vmcnt(0)" ::: "memory");
        }
    }
    __syncthreads();
}

struct Args { const float* in[26]; float* out; unsigned char* ws; int ph_lo, ph_hi; };
enum { I_X = 0, I_MEM, I_WIN, I_BGATE, I_CONVW, I_GWS, I_GB, I_GLNG, I_GLNB, I_MLNG, I_MLNB, I_WKV, I_WCP, I_WGP, I_WXP, I_WOUT, I_LN1G, I_LN1B, I_WR, I_BR, I_WGU, I_BGU, I_WDN, I_BDN, I_LN2G, I_LN2B };

__device__ __forceinline__ void transpose_item(const float* W, int N, bf16_t* dst, int K, LAS float* scr, int lane, bool spread = false) {
#pragma unroll 8
    for (int i = 0; i < 32; ++i) { const int kk = 2 * i + (lane >> 5); scr[kk * 33 + (lane & 31)] = __builtin_nontemporal_load(W + (size_t)kk * N + (lane & 31)); }
    LDS_WAIT(); asm volatile("" ::: "memory");
    const int c = lane & 7;
#pragma unroll
    for (int j = 0; j < 4; ++j) { const int n = (lane >> 3) + 8 * j; const LAS float* s = scr + (8 * c) * 33 + n;
        u32x4 o; o.x = cvt_pk_bf16(s[0 * 33], s[1 * 33]); o.y = cvt_pk_bf16(s[2 * 33], s[3 * 33]); o.z = cvt_pk_bf16(s[4 * 33], s[5 * 33]); o.w = cvt_pk_bf16(s[6 * 33], s[7 * 33]);
        const int nr = spread ? ((n >> 3) * 16 + (n & 7)) : n; *(GAS u32x4*)(dst + (size_t)nr * K + 8 * c) = o; }
    LDS_WAIT(); asm volatile("" ::: "memory");
}
__device__ __forceinline__ void transpose_item_f8(const float* W, int N, unsigned char* dst, LAS float* scr, int lane, bool spread = false) {
#pragma unroll 8
    for (int i = 0; i < 64; ++i) { const int kk = 2 * i + (lane >> 5); scr[kk * 33 + (lane & 31)] = __builtin_nontemporal_load(W + (size_t)kk * N + (lane & 31)) * W8_SCALE; }
    LDS_WAIT(); asm volatile("" ::: "memory");
    const int c = lane & 7;
#pragma unroll
    for (int j = 0; j < 4; ++j) { const int n = (lane >> 3) + 8 * j; const LAS float* sp = scr + (16 * c) * 33 + n;
        u32x4 o; o.x = cvt4_fp8(sp[0 * 33], sp[1 * 33], sp[2 * 33], sp[3 * 33]); o.y = cvt4_fp8(sp[4 * 33], sp[5 * 33], sp[6 * 33], sp[7 * 33]);
        o.z = cvt4_fp8(sp[8 * 33], sp[9 * 33], sp[10 * 33], sp[11 * 33]); o.w = cvt4_fp8(sp[12 * 33], sp[13 * 33], sp[14 * 33], sp[15 * 33]);
        const int nr = spread ? ((n >> 3) * 16 + (n & 7)) : n; __builtin_nontemporal_store(o, (GAS u32x4*)(dst + (size_t)nr * 1024 + 16 * c)); }
    LDS_WAIT(); asm volatile("" ::: "memory");
}
__device__ __forceinline__ void ln_row_affine_f8(const float* xrow, const float* g, const float* b, unsigned char* orow, int lane) {
    const f32x4* xr = (const f32x4*)xrow + lane;
    f32x4 v[4]; float s = 0.f;
#pragma unroll
    for (int j = 0; j < 4; ++j) { v[j] = xr[64 * j]; s += (v[j].x + v[j].y) + (v[j].z + v[j].w); }
    const float mean = wave_sum(s) * (1.f / D); float s2 = 0.f;
#pragma unroll
    for (int j = 0; j < 4; ++j) { v[j] = v[j] - mean; s2 += (v[j].x * v[j].x + v[j].y * v[j].y) + (v[j].z * v[j].z + v[j].w * v[j].w); }
    const float rstd = 1.f / sqrtf(wave_sum(s2) * (1.f / D) + LN_EPS);
    unsigned* o8 = (unsigned*)orow + lane;
#pragma unroll
    for (int j = 0; j < 4; ++j) { const f32x4 gg = ((const f32x4*)g)[lane + 64 * j], bb = ((const f32x4*)b)[lane + 64 * j]; const f32x4 y = v[j] * rstd * gg + bb;
        o8[64 * j] = cvt4_fp8(y.x, y.y, y.z, y.w); }
}

constexpr int NPH = 9;
__global__ void __launch_bounds__(NTHR, 2) fwd(Args args) {
    extern __shared__ __attribute__((aligned(16))) unsigned char lds_raw[];
    LAS unsigned char* lds = (LAS unsigned char*)lds_raw;
    volatile LAS unsigned* MISC = (volatile LAS unsigned*)(lds + MISC_OFF);
    const int wave = __builtin_amdgcn_readfirstlane((int)threadIdx.x >> 6);
#define FRESH_IDS() int lane = lane_id(); asm volatile("" : "+v"(lane)); const int tid = wave * 64 + lane; (void)tid
    const int G = gridDim.x, bx = blockIdx.x;
    const int vcu = (G % 8 == 0) ? (bx % 8) * (G / 8) + bx / 8 : bx;
    unsigned char* ws = args.ws;
    unsigned* ctl = (unsigned*)(ws + WS_CTL);
    for (int u = threadIdx.x; u < (LDS_BYTES - MISC_OFF) / 4; u += NTHR) MISC[u] = 0u;
    __syncthreads();
    XcdBarrier bar; bar.bar = ctl + CW_BAR; bar.x = 0; bar.st = MISC;
    if (MK_N_LAUNCHES == 1) bar = xcd_barrier_post(ctl + CW_BAR, MISC);
#define GRID_BAR() do { if (MK_N_LAUNCHES == 1) xcd_barrier(bar); } while (0)
    const int lo = args.ph_lo, hi = args.ph_hi;
#ifndef PH_MASK
#define PH_MASK 0x1ff
#endif
#define IN(k) (((PH_MASK >> (k)) & 1) && lo <= (k) && (k) < hi)
#define BOTH(k) (IN(k) && IN((k) + 1))
    const int gw = vcu * NWAVES + wave, NGW = G * NWAVES;
    bf16_t* const Zb = (bf16_t*)(ws + WS_Z);

    if (IN(0)) {
        FRESH_IDS();
        LAS float* scr = (LAS float*)(lds + wave * 16896);
        constexpr int I_IN = 16 * 160, I_KV = 16 * 64, I_PJ = 16 * 32, I_GU = 8 * 64, I_DN = 8 * 32;
        constexpr int N0 = I_IN, N1 = N0, N2 = N1, N3 = N2 + I_PJ, N4 = N3 + 32 * I_GU, N5 = N4 + 32 * I_DN;
        constexpr int I_IN8 = 8 * 128, I_WX8 = 8 * 32, N6 = N5 + I_IN8, N7 = N6 + 3 * I_WX8, N8E = N7 + 8 * 64;
        for (int it = gw; it < N8E; it += NGW) {
            if (it >= N5) {
                int r8 = it - N5, N8 = NZ, nb8 = 128; const float* src = args.in[I_WIN] + 5120; unsigned char* dbase = ws + WS_WIN8;
                if (it >= N7) { r8 = it - N7; N8 = 2048; nb8 = 64; src = args.in[I_WKV]; dbase = ws + WS_WKV; }
                else if (it >= N6) { r8 = it - N6; const int br = r8 / I_WX8; r8 -= br * I_WX8; N8 = 1024; nb8 = 32; src = args.in[I_WCP + br]; dbase = ws + WS_WP8 + (size_t)br * MiB; }
                const int kb = r8 / nb8, nb = r8 - kb * nb8, k0 = 128 * kb, n0 = 32 * nb;
                const float* W8 = src + (size_t)k0 * N8 + n0;
                unsigned char* d8 = dbase + (size_t)n0 * 1024 + k0;
                transpose_item_f8(W8, N8, d8, scr, lane); continue; }
            if (it >= N3) {
                int r8 = it - N3; const bool dn = r8 >= 32 * I_GU; if (dn) r8 -= 32 * I_GU; const int per = dn ? I_DN : I_GU, e = r8 / per; r8 -= e * per;
                const int N8 = dn ? 1024 : 2048, nb8 = N8 / 32, kb = r8 / nb8, nb = r8 - kb * nb8, k0 = 128 * kb, n0 = 32 * nb; int drow = n0;
                if (!dn) { const int j0 = n0 & 1023; drow = (j0 >> 7) * 256 + ((j0 & 127) >> 3) * 16 + (n0 >> 10) * 8; }
                const float* W8 = (dn ? args.in[I_WDN] + (size_t)e * 1024 * 1024 : args.in[I_WGU] + (size_t)e * 1024 * 2048) + (size_t)k0 * N8 + n0;
                unsigned char* d8 = (dn ? ws + WS_WDN + (size_t)e * 1024 * 1024 : ws + WS_WGU + (size_t)e * 2048 * 1024) + (size_t)drow * 1024 + k0;
                transpose_item_f8(W8, N8, d8, scr, lane, !dn); continue; }
            const float* W; int N, nblk, r; bf16_t* dst; int kind;
            if (it < N0) { r = it; W = args.in[I_WIN]; N = NZ; dst = (bf16_t*)(ws + WS_WIN); kind = 2; }
            else if (it < N3) { r = it - N2; W = args.in[I_WOUT]; N = 1024; dst = (bf16_t*)(ws + WS_WOUT); kind = 0; }
            else if (it < N4) { r = it - N3; const int e = r / I_GU; r -= e * I_GU; W = args.in[I_WGU] + (size_t)e * 1024 * 2048; N = 2048; dst = (bf16_t*)(ws + WS_WGU) + (size_t)e * 2048 * 1024; kind = 1; }
            else { r = it - N4; const int e = r / I_DN; r -= e * I_DN; W = args.in[I_WDN] + (size_t)e * 1024 * 1024; N = 1024; dst = (bf16_t*)(ws + WS_WDN) + (size_t)e * 1024 * 1024; kind = 0; }
            nblk = (kind == 2) ? 160 : N / 32; const int kb = r / nblk, nb = r - kb * nblk, k0 = 64 * kb, n0 = 32 * nb;
            int drow = n0; bool spr = false;
            if (kind == 2 && n0 >= 1024 && n0 < 3072) { const int j0 = (n0 - 1024) & 1023, hf = (n0 - 1024) >> 10; drow = 1024 + (j0 >> 7) * 256 + ((j0 & 127) >> 3) * 16 + hf * 8; spr = true; }
            transpose_item(W + (size_t)k0 * N + n0, N, dst + (size_t)drow * 1024 + k0, 1024, scr, lane, spr);
        }
        { const f32x4* xs = (const f32x4*)args.in[I_X]; u32x4* xd = (u32x4*)(ws + WS_XB);
          for (size_t i = (size_t)gw * 64 + lane; i < (size_t)T * D / 8; i += (size_t)NGW * 64) { const f32x4 a = __builtin_nontemporal_load(xs + 2 * i), b = __builtin_nontemporal_load(xs + 2 * i + 1);
              u32x4 w; w.x = cvt_pk_bf16(a.x, a.y); w.y = cvt_pk_bf16(a.z, a.w); w.z = cvt_pk_bf16(b.x, b.y); w.w = cvt_pk_bf16(b.z, b.w); xd[i] = w;
              u32x2 q8; q8.x = cvt4_fp8(a.x, a.y, a.z, a.w); q8.y = cvt4_fp8(b.x, b.y, b.z, b.w); ((u32x2*)(ws + WS_X8))[i] = q8; } }
        for (int m = gw; m < MEMR; m += NGW) ln_row_affine_f8(args.in[I_MEM] + (size_t)m * D, args.in[I_MLNG], args.in[I_MLNB], ws + WS_MEMNB + (size_t)m * D, lane);
        { bf16_t* wt = (bf16_t*)(ws + WS_WTRIL); const float* gs = args.in[I_GWS];
          for (int i = gw * 64 + lane; i < 8 * 128 * 128; i += NGW * 64) { const int tt = (i >> 7) & 127, s = i & 127; const float v = (s <= tt) ? gs[i] : 0.f; wt[i] = (bf16_t)(cvt_pk_bf16(v, 0.f) & 0xffffu); } }
        { bf16_t* wh = (bf16_t*)(ws + WS_WRHI); bf16_t* wl = (bf16_t*)(ws + WS_WRLO); const float* wrp = args.in[I_WR];
          for (int i = gw * 64 + lane; i < 32 * 1024; i += NGW * 64) { const int e = i >> 10, k = i & 1023; const float v = wrp[k * 32 + e];
              const unsigned h = cvt_pk_bf16(v, 0.f) & 0xffffu; const float r = v - __uint_as_float(h << 16); wh[i] = (bf16_t)h; wl[i] = (bf16_t)(cvt_pk_bf16(r, 0.f) & 0xffffu); } }
        if (BOTH(0)) GRID_BAR();
    }

    if (IN(1)) {
        { SchedKV S{(const char*)(ws + WS_MEMNB), (const char*)(ws + WS_WKV), bx};
          EpiKV E{ws + WS_KMAT, ws + WS_VT};
          pg8::gemm_phase<EpiKV, SchedKV, false, PG8_SP2, true>(lds, wave, 512, 512, 512, S, E); }
        { SchedDense S{(const char*)(ws + WS_XB), (const char*)(ws + WS_WIN), T / 256, 20, G, bx, (size_t)256 * 2048, (size_t)256 * 2048};
          S.reps = (DUP_PHASE == 1) ? 2 : 1; EpiZ E{Zb, args.in[I_BGATE], 0, 1.0f, (f32x2*)(ws + WS_GSTAT)};
          pg8::gemm_phase<EpiZ, SchedDense, true, PG8_SP2>(lds, wave, 1024, 1024, 1024, S, E); }
        { SchedDense S{(const char*)(ws + WS_X8), (const char*)(ws + WS_WIN8), T / 256, 16, G, bx, (size_t)256 * 1024, (size_t)256 * 1024};
          S.reps = (DUP_PHASE == 1) ? 2 : 1; EpiZ E{Zb, args.in[I_BGATE], 20, W8_INV};
          pg8::gemm_phase<EpiZ, SchedDense, true, PG8_SP2, true>(lds, wave, 512, 512, 512, S, E); }
        if (BOTH(1)) GRID_BAR();
    }

    if (IN(2)) {
        FRESH_IDS();
#ifndef P2_SUB
#define P2_SUB 7
#endif
        if (P2_SUB & 1) {
            const bf16_t* pp = Zb + (size_t)1 * (ZSTRIDE / 2); const bf16_t* cb = Zb; unsigned char* yc8 = ws + WS_YB8;
            const float* cw = args.in[I_CONVW];
            for (int it = gw; it < (T / 16) * 2; it += NGW) {
                const int rb = it >> 1, c0 = (it & 1) * 512 + lane * 8, m0 = rb * 16, t0 = m0 & (SEQ - 1);
                float w0[8], w1[8], w2[8], p1[8], p2[8];
#pragma unroll
                for (int j = 0; j < 8; ++j) { w0[j] = cw[c0 + j]; w1[j] = cw[1024 + c0 + j]; w2[j] = cw[2048 + c0 + j]; p1[j] = 0.f; p2[j] = 0.f; }
                if (t0 >= 2) {
                    const u32x4 a1 = *(const u32x4*)(pp + (size_t)(m0 - 1) * D + c0), a2 = *(const u32x4*)(pp + (size_t)(m0 - 2) * D + c0);
                    p1[0] = bf_lo(a1.x); p1[1] = bf_hi(a1.x); p1[2] = bf_lo(a1.y); p1[3] = bf_hi(a1.y); p1[4] = bf_lo(a1.z); p1[5] = bf_hi(a1.z); p1[6] = bf_lo(a1.w); p1[7] = bf_hi(a1.w);
                    p2[0] = bf_lo(a2.x); p2[1] = bf_hi(a2.x); p2[2] = bf_lo(a2.y); p2[3] = bf_hi(a2.y); p2[4] = bf_lo(a2.z); p2[5] = bf_hi(a2.z); p2[6] = bf_lo(a2.w); p2[7] = bf_hi(a2.w);
                }
#pragma unroll 4
                for (int r = 0; r < 16; ++r) {
                    const size_t o = (size_t)(m0 + r) * D + c0;
                    const u32x4 a = *(const u32x4*)(pp + o), bq = *(const u32x4*)(cb + o);
                    float p0[8], bb[8], y[8];
                    p0[0] = bf_lo(a.x); p0[1] = bf_hi(a.x); p0[2] = bf_lo(a.y); p0[3] = bf_hi(a.y); p0[4] = bf_lo(a.z); p0[5] = bf_hi(a.z); p0[6] = bf_lo(a.w); p0[7] = bf_hi(a.w);
                    bb[0] = bf_lo(bq.x); bb[1] = bf_hi(bq.x); bb[2] = bf_lo(bq.y); bb[3] = bf_hi(bq.y); bb[4] = bf_lo(bq.z); bb[5] = bf_hi(bq.z); bb[6] = bf_lo(bq.w); bb[7] = bf_hi(bq.w);
#pragma unroll
                    for (int j = 0; j < 8; ++j) { y[j] = bb[j] * (w0[j] * p2[j] + w1[j] * p1[j] + w2[j] * p0[j]); p2[j] = p1[j]; p1[j] = p0[j]; }
#pragma unroll
                    for (int j = 0; j < 8; ++j) y[j] = fminf(fmaxf(y[j], -448.f), 448.f);
                    u32x2 w; w.x = cvt4_fp8(y[0], y[1], y[2], y[3]); w.y = cvt4_fp8(y[4], y[5], y[6], y[7]);
                    *(u32x2*)(yc8 + o) = w;
                }
            }
        }
        if (P2_SUB & 2) {
            const bf16_t* gu = Zb + (size_t)3 * (ZSTRIDE / 2); const bf16_t* gv = Zb + (size_t)4 * (ZSTRIDE / 2); unsigned char* yg8 = ws + WS_YB8 + 32 * MiB;
            const bf16_t* wtril = (const bf16_t*)(ws + WS_WTRIL);
            const float* lng = args.in[I_GLNG]; const float* lnb = args.in[I_GLNB]; const float* gbias = args.in[I_GB];
            LAS float* stat = (LAS float*)(lds);
            constexpr int VT_ROW = 136;
            LAS bf16_t* vT0 = (LAS bf16_t*)(lds + 2048);
            for (int ch = vcu; ch < T / 128; ch += G) {
                const int m0 = ch * 128;
                __syncthreads();
                if (lane < 16) { const int r = wave * 16 + lane; const f32x4* sp = (const f32x4*)((const f32x2*)(ws + WS_GSTAT) + (size_t)(m0 + r) * 16); float s1 = 0.f, s2 = 0.f;
#pragma unroll
                    for (int j = 0; j < 8; ++j) { const f32x4 q = sp[j]; s1 += q.x + q.z; s2 += q.y + q.w; }
                    const float mean = s1 * (1.f / D), var = fmaxf(s2 * (1.f / D) - mean * mean, 0.f);
                    stat[2 * r] = mean; stat[2 * r + 1] = 1.f / sqrtf(var + LN_EPS); }
                const int fi = lane & 15, fq = lane >> 4, tt = wave * 16 + fi; const int nks = (wave * 16 + 15) / 32 + 1;
                u32x4 av[4];
#pragma unroll
                for (int q = 0; q < 4; ++q) { const int c8 = wave * 2 + (q & 1), sr = (q >> 1) * 64 + lane; av[q] = *(const u32x4*)(gv + (size_t)(m0 + sr) * D + c8 * 8); }
                __syncthreads();
                for (int g = 0; g < 8; ++g) {
                    LAS bf16_t* vT = vT0 + (g & 1) * (128 * VT_ROW);
#pragma unroll
                    for (int q = 0; q < 4; ++q) {
                        const int c8 = wave * 2 + (q & 1), sr = (q >> 1) * 64 + lane, cg = g * 128 + c8 * 8;
                        const u32x4 a = av[q];
                        const float mean = stat[2 * sr], rstd = stat[2 * sr + 1];
                        const f32x4 g0 = *(const f32x4*)(lng + cg), g1 = *(const f32x4*)(lng + cg + 4), b0 = *(const f32x4*)(lnb + cg), b1 = *(const f32x4*)(lnb + cg + 4);
                        float v[8]; v[0] = bf_lo(a.x); v[1] = bf_hi(a.x); v[2] = bf_lo(a.y); v[3] = bf_hi(a.y); v[4] = bf_lo(a.z); v[5] = bf_hi(a.z); v[6] = bf_lo(a.w); v[7] = bf_hi(a.w);
#pragma unroll
                        for (int j = 0; j < 8; ++j) { const float gg = j < 4 ? g0[j & 3] : g1[j & 3], bb = j < 4 ? b0[j & 3] : b1[j & 3]; const float y = (v[j] - mean) * rstd * gg + bb;
                            vT[((2 * (c8 >> 2) + (j >> 2)) * 16 + 4 * (c8 & 3) + (j & 3)) * VT_ROW + sr] = (bf16_t)(cvt_pk_bf16(y, 0.f) & 0xffffu); }
                    }
                    if (g < 7) {
#pragma unroll
                        for (int q = 0; q < 4; ++q) { const int c8 = wave * 2 + (q & 1), sr = (q >> 1) * 64 + lane; av[q] = *(const u32x4*)(gv + (size_t)(m0 + sr) * D + (g + 1) * 128 + c8 * 8); } }
                    const size_t uo = (size_t)(m0 + tt) * D + g * 128 + 8 * fq;
                    u32x4 uu[4];
#pragma unroll
                    for (int k = 0; k < 4; ++k) uu[k] = *(const u32x4*)(gu + uo + k * 32);
                    const float bs = gbias[g * 128 + tt];
                    __syncthreads();
                    f32x4 acc[8];
#pragma unroll
                    for (int n = 0; n < 8; ++n) acc[n] = (f32x4){0.f, 0.f, 0.f, 0.f};
                    const bf16_t* wrow = wtril + ((size_t)g * 128 + wave * 16 + fi) * 128 + fq * 8;
                    for (int ks = 0; ks < nks; ++ks) {
                        const bf16x8 bfrag = *(const bf16x8*)(wrow + ks * 32);
#pragma unroll
                        for (int n = 0; n < 8; ++n) { const bf16x8 afrag = *(const LAS bf16x8*)(vT + (n * 16 + fi) * VT_ROW + ks * 32 + fq * 8);
                            acc[n] = __builtin_amdgcn_mfma_f32_16x16x32_bf16(afrag, bfrag, acc[n], 0, 0, 0); }
                    }
#pragma unroll
                    for (int k = 0; k < 4; ++k) { const u32x4 u4 = uu[k]; const f32x4 a0 = acc[2 * k] + bs, a1 = acc[2 * k + 1] + bs;
                        f32x4 y0 = {bf_lo(u4.x) * a0[0], bf_hi(u4.x) * a0[1], bf_lo(u4.y) * a0[2], bf_hi(u4.y) * a0[3]}, y1 = {bf_lo(u4.z) * a1[0], bf_hi(u4.z) * a1[1], bf_lo(u4.w) * a1[2], bf_hi(u4.w) * a1[3]};
#pragma unroll
                        for (int j = 0; j < 4; ++j) { y0[j] = fminf(fmaxf(y0[j], -448.f), 448.f); y1[j] = fminf(fmaxf(y1[j], -448.f), 448.f); }
                        u32x2 w; w.x = cvt4_fp8(y0[0], y0[1], y0[2], y0[3]); w.y = cvt4_fp8(y1[0], y1[1], y1[2], y1[3]); *(u32x2*)(yg8 + uo + k * 32) = w; }
                }
            }
            __syncthreads();
        }
        if (P2_SUB & 4) {
            bf16_t* qp = Zb + (size_t)5 * (ZSTRIDE / 2);
            { SchedAttn S{(const char*)qp, (const char*)(ws + WS_KMAT), 0, G, bx};
              EpiAttnS E{(unsigned char*)qp, (LAS float*)(lds + EPI_OFF)};
              pg8::gemm_phase<EpiAttnS, SchedAttn, true, false, true>(lds, wave, 128, 512, 512, S, E); }
            VM_WAIT(); __syncthreads();
            { SchedAttn S{(const char*)qp, (const char*)(ws + WS_VT), 1, G, bx};
              EpiAttnO E{ws + WS_X8};
              pg8::gemm_phase<EpiAttnO, SchedAttn, true, false, true>(lds, wave, 128, 512, 1024, S, E); }
        }
        if (BOTH(2)) GRID_BAR();
    }

    if (IN(3)) {
        { SchedMerge S{(const char*)(ws + WS_YB8), (const char*)(ws + WS_X8), (const char*)(ws + WS_WP8), G, bx};
          S.reps = (DUP_PHASE == 3) ? 2 : 1; EpiMerge E{Zb, (bf16_t*)(ws + WS_MERGED)};
          pg8::gemm_phase<EpiMerge, SchedMerge, true, PG8_SP2, true>(lds, wave, 512, 512, 512, S, E); }
        if (BOTH(3)) GRID_BAR();
    }

    if (IN(4)) {
        SchedDense S{(const char*)(ws + WS_MERGED), (const char*)(ws + WS_WOUT), T / 256, 4, G, bx, (size_t)256 * 2048, (size_t)256 * 2048};
        S.reps = (DUP_PHASE == 4) ? 2 : 1; EpiResid E{(const bf16_t*)(ws + WS_XB), (bf16_t*)(ws + WS_X1H)};
        pg8::gemm_phase<EpiResid, SchedDense, true, PG8_SP2>(lds, wave, 1024, 1024, 1024, S, E);
        if (BOTH(4)) GRID_BAR();
    }

    if (IN(5)) {
        FRESH_IDS();
        LAS float* lgs = (LAS float*)(lds) + wave * 512;
        volatile LAS unsigned* lcnt = MISC + 96; volatile LAS unsigned* lbase = MISC + 128;
        const bf16_t* wh = (const bf16_t*)(ws + WS_WRHI); const bf16_t* wl = (const bf16_t*)(ws + WS_WRLO);
        unsigned char* x1q = ws + WS_X1B;
        const float* g1 = args.in[I_LN1G]; const float* b1 = args.in[I_LN1B]; const float* brt = args.in[I_BR];
        int* perm = (int*)(ws + WS_PERM); float* sgate = (float*)(ws + WS_SGATE); unsigned* tok = (unsigned*)(ws + WS_TOK);
        const int nblk = T / 16, niter = (nblk + NGW - 1) / NGW;
        for (int itn = 0; itn < niter; ++itn) {
            const int rb = itn * NGW + gw; const bool active = rb < nblk; const int m0 = rb * 16;
            if (tid < 32) lcnt[tid] = 0u;
            __syncthreads();
            int se[4] = {0, 0, 0, 0}; unsigned sl[4] = {0u, 0u, 0u, 0u}; float sg[4] = {0.f, 0.f, 0.f, 0.f};
            if (active) {
                bf16_t* x1h = (bf16_t*)(ws + WS_X1H);
                f32x4 ga[2], gb[2], ba[2], bb[2];
#pragma unroll
                for (int j = 0; j < 2; ++j) { ga[j] = ((const f32x4*)g1)[2 * lane + 128 * j]; gb[j] = ((const f32x4*)g1)[2 * lane + 128 * j + 1]; ba[j] = ((const f32x4*)b1)[2 * lane + 128 * j]; bb[j] = ((const f32x4*)b1)[2 * lane + 128 * j + 1]; }
                for (int r0 = 0; r0 < 16; r0 += 4) {
                    u32x4 q[4][2];
#pragma unroll
                    for (int h = 0; h < 4; ++h)
#pragma unroll
                        for (int j = 0; j < 2; ++j) q[h][j] = ((const u32x4*)(x1h + (size_t)(m0 + r0 + h) * D) + lane)[64 * j];
#pragma unroll
                    for (int h = 0; h < 4; ++h) { const int r = r0 + h;
                        u32x4* xr = (u32x4*)(x1h + (size_t)(m0 + r) * D) + lane;
                        float v[16]; float s = 0.f;
#pragma unroll
                        for (int j = 0; j < 2; ++j) { const u32x4 qq = q[h][j]; v[8 * j + 0] = bf_lo(qq.x); v[8 * j + 1] = bf_hi(qq.x); v[8 * j + 2] = bf_lo(qq.y); v[8 * j + 3] = bf_hi(qq.y);
                            v[8 * j + 4] = bf_lo(qq.z); v[8 * j + 5] = bf_hi(qq.z); v[8 * j + 6] = bf_lo(qq.w); v[8 * j + 7] = bf_hi(qq.w); }
#pragma unroll
                        for (int j = 0; j < 16; ++j) s += v[j];
                        const float mean = wave_sum(s) * (1.f / D); float s2 = 0.f;
#pragma unroll
                        for (int j = 0; j < 16; ++j) { v[j] -= mean; s2 += v[j] * v[j]; }
                        const float rstd = 1.f / sqrtf(wave_sum(s2) * (1.f / D) + LN_EPS);
                        u32x2* o8 = (u32x2*)(x1q + (size_t)(m0 + r) * D) + lane;
#pragma unroll
                        for (int j = 0; j < 2; ++j) { float y[8];
#pragma unroll
                            for (int i = 0; i < 4; ++i) { y[i] = v[8 * j + i] * rstd * ga[j][i] + ba[j][i]; y[4 + i] = v[8 * j + 4 + i] * rstd * gb[j][i] + bb[j][i]; }
                            u32x4 w; w.x = cvt_pk_bf16(y[0], y[1]); w.y = cvt_pk_bf16(y[2], y[3]); w.z = cvt_pk_bf16(y[4], y[5]); w.w = cvt_pk_bf16(y[6], y[7]); xr[64 * j] = w;
                            u32x2 q8; q8.x = cvt4_fp8(y[0], y[1], y[2], y[3]); q8.y = cvt4_fp8(y[4], y[5], y[6], y[7]); o8[64 * j] = q8; } }
                }
                VM_WAIT();
                const int fi = lane & 15, fq = lane >> 4;
                f32x4 la[2] = {(f32x4){0.f, 0.f, 0.f, 0.f}, (f32x4){0.f, 0.f, 0.f, 0.f}};
                const bf16_t* xrow = x1h + (size_t)(m0 + fi) * D + fq * 8;
                const bf16_t* whr = wh + (size_t)fi * 1024 + fq * 8; const bf16_t* wlr = wl + (size_t)fi * 1024 + fq * 8;
#pragma unroll 4
                for (int s = 0; s < 32; ++s) {
                    const bf16x8 ah = *(const bf16x8*)(xrow + s * 32);
#pragma unroll
                    for (int n = 0; n < 2; ++n) { const bf16x8 bh = *(const bf16x8*)(whr + (size_t)n * 16 * 1024 + s * 32), bl = *(const bf16x8*)(wlr + (size_t)n * 16 * 1024 + s * 32);
                        la[n] = __builtin_amdgcn_mfma_f32_16x16x32_bf16(ah, bh, la[n], 0, 0, 0);
                        la[n] = __builtin_amdgcn_mfma_f32_16x16x32_bf16(ah, bl, la[n], 0, 0, 0); }
                }
#pragma unroll
                for (int n = 0; n < 2; ++n)
#pragma unroll
                    for (int r = 0; r < 4; ++r) lgs[(4 * fq + r) * 32 + 16 * n + fi] = la[n][r];
                LDS_WAIT(); asm volatile("" ::: "memory");
                if (lane < 16) {
                    float lv[32];
#pragma unroll
                    for (int e = 0; e < 32; ++e) lv[e] = lgs[lane * 32 + e] + brt[e];
                    float tv[4];
#pragma unroll
                    for (int k = 0; k < 4; ++k) { float best = -3.0e38f; int bi = 0;
#pragma unroll
                        for (int e = 0; e < 32; ++e) { const bool tk = lv[e] > best; best = tk ? lv[e] : best; bi = tk ? e : bi; }
                        tv[k] = best; se[k] = bi;
#pragma unroll
                        for (int e = 0; e < 32; ++e) lv[e] = (e == bi) ? -3.0e38f : lv[e]; }
                    const float e1 = fast_exp2((tv[1] - tv[0]) * LOG2E), e2 = fast_exp2((tv[2] - tv[0]) * LOG2E), e3 = fast_exp2((tv[3] - tv[0]) * LOG2E);
                    const float inv = 1.0f / (1.0f + e1 + e2 + e3);
                    sg[0] = inv; sg[1] = e1 * inv; sg[2] = e2 * inv; sg[3] = e3 * inv;
#pragma unroll
                    for (int k = 0; k < 4; ++k) sl[k] = __hip_atomic_fetch_add((LAS unsigned*)(lcnt + se[k]), 1u, __ATOMIC_RELAXED, __HIP_MEMORY_SCOPE_WORKGROUP);
                }
            }
            __syncthreads();
            if (tid < 32) { const unsigned c = lcnt[tid]; lbase[tid] = c ? __hip_atomic_fetch_add(ctl + CW_CNT + 64 * tid, c, RLX_AGENT) : 0u; }
            __syncthreads();
            if (active && lane < 16) {
                const int t = m0 + lane; u32x4 tk;
#pragma unroll
                for (int k = 0; k < 4; ++k) { const unsigned pos = lbase[se[k]] + sl[k]; perm[(size_t)se[k] * 32768 + pos] = t; sgate[(size_t)se[k] * 32768 + pos] = sg[k]; tk[k] = ((unsigned)se[k] << 16) | pos; }
                *(u32x4*)(tok + (size_t)t * 4) = tk;
            }
            __syncthreads();
        }
        if (BOTH(5)) GRID_BAR();
    }

    if (IN(6) || IN(7) || IN(8)) {
        if (threadIdx.x == 0) { int p = 0;
            for (int e = 0; e < 32; ++e) { const int c = (int)__hip_atomic_load(ctl + CW_CNT + 64 * e, RLX_AGENT); MISC[8 + e] = (unsigned)p; MISC[48 + e] = (unsigned)c; p += (c + 255) >> 8; }
            MISC[8 + 32] = (unsigned)p; }
        __syncthreads();
    }
    const LAS int* pref = (const LAS int*)(MISC + 8); const LAS int* ecnt = (const LAS int*)(MISC + 48);

    if (IN(6)) {
        SchedMoe<true> S{(const char*)(ws + WS_X1B), (const char*)(ws + WS_WGU), (const int*)(ws + WS_PERM), pref, ecnt, 8, G, bx, (size_t)2048 * 1024, (size_t)256 * 1024};
        S.reps = (DUP_PHASE == 6) ? 2 : 1; EpiAct E{ws + WS_ACT, args.in[I_BGU]};
        pg8::gemm_phase<EpiAct, SchedMoe<true>, true, false, true>(lds, wave, 512, 512, 512, S, E);
        if (BOTH(6)) GRID_BAR();
    }

    if (IN(7)) {
        SchedMoe<false> S{(const char*)(ws + WS_ACT), (const char*)(ws + WS_WDN), (const int*)(ws + WS_PERM), pref, ecnt, 4, G, bx, (size_t)1024 * 1024, (size_t)256 * 1024};
        S.reps = (DUP_PHASE == 7) ? 2 : 1; EpiDown E{ws + WS_EO, args.in[I_BDN], (const float*)(ws + WS_SGATE), pref};
        pg8::gemm_phase<EpiDown, SchedMoe<false>, true, PG8_SP2, true>(lds, wave, 512, 512, 512, S, E);
        if (BOTH(7)) GRID_BAR();
    }

    if (IN(8)) {
        FRESH_IDS();
        const unsigned char* eo = ws + WS_EO; const unsigned* tok = (const unsigned*)(ws + WS_TOK); const float* sgp = (const float*)(ws + WS_SGATE);
        const float* g2 = args.in[I_LN2G]; const float* b2 = args.in[I_LN2B];
        const int nrow = (T - gw + NGW - 1) / NGW;
        f32x4 gg[4], bb[4];
#pragma unroll
        for (int j = 0; j < 4; ++j) { gg[j] = ((const f32x4*)g2)[lane + 64 * j]; bb[j] = ((const f32x4*)b2)[lane + 64 * j]; }
        for (int k0 = 0; k0 < nrow; k0 += 64) {
            u32x4 tkv = (u32x4){0u, 0u, 0u, 0u}; if (k0 + lane < nrow) tkv = *(const u32x4*)(tok + (size_t)(gw + (k0 + lane) * NGW) * 4);
            const int kend = (nrow - k0) < 64 ? (nrow - k0) : 64;
            for (int kk = 0; kk < kend; kk += 2) {
                u32x2 ld[2][4]; unsigned l8[2][4][4]; float gk[2][4]; int mrow[2]; bool act2[2];
#pragma unroll
                for (int h = 0; h < 2; ++h) { const int kr = kk + h; act2[h] = kr < kend; const int krc = act2[h] ? kr : kk; mrow[h] = gw + (k0 + krc) * NGW;
                    const u32x2* hr = (const u32x2*)((const bf16_t*)(ws + WS_X1H) + (size_t)mrow[h] * D) + lane;
#pragma unroll
                    for (int j = 0; j < 4; ++j) ld[h][j] = hr[64 * j];
#pragma unroll
                    for (int q = 0; q < 4; ++q) { const unsigned tw = (unsigned)__builtin_amdgcn_readlane((int)tkv[q], krc); const unsigned e = tw >> 16, pos = tw & 0xffffu; const size_t slot = (size_t)pref[e] * 256 + pos;
                        gk[h][q] = sgp[(size_t)e * 32768 + pos] * EO8_INV;
                        const unsigned* er = (const unsigned*)(eo + slot * D) + lane;
#pragma unroll
                        for (int j = 0; j < 4; ++j) l8[h][q][j] = __builtin_nontemporal_load(er + 64 * j); } }
#pragma unroll
                for (int h = 0; h < 2; ++h) { if (!act2[h]) continue;
                    f32x4 v[4];
#pragma unroll
                    for (int j = 0; j < 4; ++j) { const u32x2 w = ld[h][j]; v[j].x = bf_lo(w.x) * ALPHA; v[j].y = bf_hi(w.x) * ALPHA; v[j].z = bf_lo(w.y) * ALPHA; v[j].w = bf_hi(w.y) * ALPHA; }
#pragma unroll
                    for (int q = 0; q < 4; ++q)
#pragma unroll
                        for (int j = 0; j < 4; ++j) { const int w = (int)l8[h][q][j]; const f32x2 lo = __builtin_amdgcn_cvt_pk_f32_fp8(w, false), hi = __builtin_amdgcn_cvt_pk_f32_fp8(w, true);
                            v[j].x += lo.x * gk[h][q]; v[j].y += lo.y * gk[h][q]; v[j].z += hi.x * gk[h][q]; v[j].w += hi.y * gk[h][q]; }
                    float s = 0.f;
#pragma unroll
                    for (int j = 0; j < 4; ++j) s += (v[j].x + v[j].y) + (v[j].z + v[j].w);
                    const float mean = wave_sum(s) * (1.f / D); float s2 = 0.f;
#pragma unroll
                    for (int j = 0; j < 4; ++j) { v[j] = v[j] - mean; s2 += (v[j].x * v[j].x + v[j].y * v[j].y) + (v[j].z * v[j].z + v[j].w * v[j].w); }
                    const float rstd = 1.f / sqrtf(wave_sum(s2) * (1.f / D) + LN_EPS);
                    f32x4* xr = (f32x4*)(args.out + (size_t)mrow[h] * D) + lane;
#pragma unroll
                    for (int j = 0; j < 4; ++j) __builtin_nontemporal_store(v[j] * rstd * gg[j] + bb[j], xr + 64 * j); }
            }
        }
    }
#undef IN
#undef BOTH
#undef GRID_BAR
}


extern "C" void kernel_launch(void* const* d_in, const int* in_sizes, int n_in, void* d_out, int out_size, void* d_ws, size_t ws_size, hipStream_t stream) {
    static int grid = 0;
    if (grid == 0) {
        if (n_in != 26 || out_size != T * D || ws_size < WS_END) { fprintf(stderr, "kernel_launch: unexpected shapes (n_in %d, out %d, ws %zu)\n", n_in, out_size, ws_size); grid = -1; return; }
        int dev = 0, cus = 0, per_cu = 0;
        if (hipGetDevice(&dev) != hipSuccess || hipDeviceGetAttribute(&cus, hipDeviceAttributeMultiprocessorCount, dev) != hipSuccess) { grid = -1; return; }
        if (hipFuncSetAttribute((const void*)fwd, hipFuncAttributeMaxDynamicSharedMemorySize, LDS_BYTES) != hipSuccess) { fprintf(stderr, "kernel_launch: hipFuncSetAttribute failed\n"); grid = -1; return; }
        if (hipOccupancyMaxActiveBlocksPerMultiprocessor(&per_cu, (const void*)fwd, NTHR, LDS_BYTES) != hipSuccess || per_cu < 1) fprintf(stderr, "kernel_launch: occupancy query reports %d\n", per_cu);
        (void)hipGetLastError();
        grid = cus;
    }
    if (grid < 0) return;
    (void)hipMemsetAsync((char*)d_ws + WS_CTL, 0, CTL_ZERO_BYTES, stream);
    Args a{};
    for (int i = 0; i < 26; ++i) a.in[i] = (const float*)d_in[i];
    a.out = (float*)d_out; a.ws = (unsigned char*)d_ws;
    if (MK_N_LAUNCHES == 1) { a.ph_lo = 0; a.ph_hi = NPH; hipLaunchKernelGGL(fwd, dim3(grid), dim3(NTHR), LDS_BYTES, stream, a); }
    else for (int p = 0; p < NPH; ++p) { a.ph_lo = p; a.ph_hi = p + 1; hipLaunchKernelGGL(fwd, dim3(grid), dim3(NTHR), LDS_BYTES, stream, a);
    }
}
```

```cpp
#include <hip/hip_runtime.h>
#include <cstdio>
#include <cstdint>

#ifndef PG8_SP2
#define PG8_SP2 true
#endif
#ifndef DUP_PHASE
#define DUP_PHASE -1
#endif
#ifndef MK_N_LAUNCHES
#define MK_N_LAUNCHES 1
#endif

#define LAS __attribute__((address_space(3)))
#define GAS __attribute__((address_space(1)))
typedef unsigned short bf16_t;
typedef short bf16x8 __attribute__((ext_vector_type(8)));
typedef float f32x4 __attribute__((ext_vector_type(4)));
typedef float f32x2 __attribute__((ext_vector_type(2)));
typedef unsigned u32x4 __attribute__((ext_vector_type(4)));
typedef unsigned u32x2 __attribute__((ext_vector_type(2)));

constexpr int T = 32768, D = 1024, SEQ = 4096, NB = 8, NZ = 9216, NE = 32, MEMR = 2048  ;
constexpr float LN_EPS = 1e-5f, ALPHA = 1.189207115002721f, LOG2E = 1.4426950408889634f;
constexpr float QSCALE = 0.0625f * LOG2E;
constexpr int NWAVES = 8, NTHR = 512;

constexpr size_t MiB = 1u << 20;
constexpr size_t WS_CTL = 0, CTL_ZERO_BYTES = 128 * 1024;
constexpr size_t WS_WTRIL = 1 * MiB;
constexpr size_t WS_WRHI = 1 * MiB + 512 * 1024;
constexpr size_t WS_WRLO = WS_WRHI + 64 * 1024;
constexpr size_t WS_WIN = 2 * MiB;
constexpr size_t WS_WKV = 20 * MiB;
constexpr size_t WS_WP8 = 24 * MiB;
constexpr size_t WS_WOUT = 30 * MiB;
constexpr size_t WS_WGU = 32 * MiB;
constexpr size_t WS_WDN = 160 * MiB;
constexpr size_t WS_X8 = 224 * MiB;
constexpr size_t WS_WIN8 = 12 * MiB;
constexpr size_t WS_X1H = 224 * MiB;
constexpr size_t WS_EO = 288 * MiB;
constexpr size_t WS_XB = 288 * MiB;
constexpr size_t WS_SCR = 352 * MiB;
constexpr size_t WS_Z = 416 * MiB;
constexpr size_t ZSTRIDE = 64 * MiB;
constexpr size_t WS_MERGED = WS_Z + 1 * ZSTRIDE;
constexpr size_t WS_YB8 = WS_Z + 2 * ZSTRIDE;
constexpr size_t WS_X1B = WS_Z + 2 * ZSTRIDE + 32 * MiB;
constexpr size_t WS_ACT = WS_Z + 3 * ZSTRIDE;
constexpr size_t WS_MEMNB = 992 * MiB;
constexpr size_t WS_KMAT = 996 * MiB;
constexpr size_t WS_VT = 1000 * MiB;
constexpr size_t WS_PERM = 1004 * MiB;
constexpr size_t WS_SGATE = 1008 * MiB;
constexpr size_t WS_TOK = 1012 * MiB;
constexpr size_t WS_GSTAT = 1013 * MiB;
constexpr size_t WS_END = 1024 * MiB;
constexpr int CW_BAR = 4096;
constexpr int CW_CNT = 16384;

constexpr int RING_BYTES = 131072, EPI_OFF = 131072, EPI_BYTES = 8192, MISC_OFF = EPI_OFF + EPI_BYTES, LDS_BYTES = 147456;
constexpr int EPI_SLOT_OFF = MISC_OFF + 1024, EPI_SLOT_BYTES = 2048;

#define LDS_WAIT() asm volatile("s_waitcnt lgkmcnt(0)" ::: "memory")
#define VM_WAIT() asm volatile("s_waitcnt vmcnt(0)" ::: "memory")
#define RLX_AGENT __ATOMIC_RELAXED, __HIP_MEMORY_SCOPE_AGENT

typedef __bf16 bf16x2_t __attribute__((ext_vector_type(2)));
__device__ __forceinline__ unsigned cvt_pk_bf16(float lo, float hi) { const f32x2 v = {lo, hi}; return __builtin_bit_cast(unsigned, __builtin_convertvector(v, bf16x2_t)); }
constexpr float EO8_SCALE = 32.0f, EO8_INV = 1.0f / 32.0f;
constexpr float W8_SCALE = 64.0f, W8_INV = 1.0f / 64.0f;
__device__ __forceinline__ unsigned cvt4_fp8(float a, float b, float c, float d) { int w = 0; w = __builtin_amdgcn_cvt_pk_fp8_f32(a, b, w, false); w = __builtin_amdgcn_cvt_pk_fp8_f32(c, d, w, true); return (unsigned)w; }
__device__ __forceinline__ unsigned cvt4_u8(float a, float b, float c, float d) { unsigned w = 0; w = __builtin_amdgcn_cvt_pk_u8_f32(a, 0, w); w = __builtin_amdgcn_cvt_pk_u8_f32(b, 1, w); w = __builtin_amdgcn_cvt_pk_u8_f32(c, 2, w); w = __builtin_amdgcn_cvt_pk_u8_f32(d, 3, w); return w; }
__device__ __forceinline__ float ub0(unsigned w) { return (float)(w & 0xffu); }
__device__ __forceinline__ float ub1(unsigned w) { return (float)((w >> 8) & 0xffu); }
__device__ __forceinline__ float ub2(unsigned w) { return (float)((w >> 16) & 0xffu); }
__device__ __forceinline__ float ub3(unsigned w) { return (float)(w >> 24); }
__device__ __forceinline__ float bf_lo(unsigned w) { return __uint_as_float(w << 16); }
__device__ __forceinline__ float bf_hi(unsigned w) { return __uint_as_float(w & 0xffff0000u); }
__device__ __forceinline__ float fast_exp2(float x) { return __builtin_amdgcn_exp2f(x); }
__device__ __forceinline__ float fast_rcp(float x) { return __builtin_amdgcn_rcpf(x); }
__device__ __forceinline__ float sigmoidf_(float x) { return fast_rcp(1.0f + fast_exp2(-LOG2E * x)); }
__device__ __forceinline__ f32x4 exp2_4(f32x4 x) { f32x4 r; r.x = fast_exp2(x.x); r.y = fast_exp2(x.y); r.z = fast_exp2(x.z); r.w = fast_exp2(x.w); return r; }
__device__ __forceinline__ f32x4 rcp_4(f32x4 x) { f32x4 r; r.x = fast_rcp(x.x); r.y = fast_rcp(x.y); r.z = fast_rcp(x.z); r.w = fast_rcp(x.w); return r; }
__device__ __forceinline__ f32x4 sigmoid_4(f32x4 x) { return rcp_4(exp2_4(x * (-LOG2E)) + 1.0f); }
__device__ __forceinline__ f32x4 gelu_tanh_4(f32x4 x) { constexpr float kk = -2.0f * 0.7978845608028654f * LOG2E; const f32x4 u = x * (x * x * (0.044715f * kk) + kk); return x * rcp_4(exp2_4(u) + 1.0f); }
__device__ __forceinline__ float gelu_tanh(float x) {
    const float u = x * (1.0f + 0.044715f * x * x);
    return x * fast_rcp(1.0f + fast_exp2(-2.0f * 0.7978845608028654f * LOG2E * u));
}
__device__ __forceinline__ int lane_id() { return (int)__builtin_amdgcn_mbcnt_hi(~0u, __builtin_amdgcn_mbcnt_lo(~0u, 0u)); }
__device__ __forceinline__ float wave_sum(float v) {
#pragma unroll
    for (int o = 1; o < 64; o <<= 1) v += __shfl_xor(v, o);
    return v;
}

constexpr int CW = 64, CQ = 16, CB = 8;
namespace pg8 {
constexpr int BM = 256, BK = 64, HALF = 128, HTB = HALF * BK * 2, STAGE_BYTES = 8 * HTB, NXCD = 8, WGM = 8;
__host__ __device__ __forceinline__ int lds_byte(int r, int c) { const int st = (r >> 4) * 2 + (c >> 5), rr = r & 15, cc = c & 31, ob = rr * 64 + cc * 2; return st * 1024 + (ob ^ (((ob >> 9) & 1) << 5)); }
__host__ __device__ __forceinline__ void stage_rc(int b, int& R, int& C) { const int st = b / 1024, sb = b % 1024, swz = sb ^ (((sb >> 9) & 1) << 5); R = (st >> 1) * 16 + swz / 64; C = (st & 1) * 32 + (swz % 64) / 2; }
__host__ __device__ __forceinline__ int perm32(int rho) { const int n = rho >> 4, i = rho & 15; return 8 * (i >> 2) + 4 * n + (i & 3); }

__device__ __forceinline__ bool tile_order(long L, int nM, int nN, int& pm, int& pn) {
    const int nwg = nM * nN; if (L >= nwg) return false;
    int wgid = (int)L; { const int q = nwg / NXCD, r = nwg % NXCD, xcd = wgid % NXCD, off = wgid / NXCD; wgid = (xcd < r ? xcd * (q + 1) : r * (q + 1) + (xcd - r) * q) + off; }
    const int nig = WGM * nN, gid = wgid / nig, fm = gid * WGM, gsz = (nM - fm) < WGM ? (nM - fm) : WGM;
    pm = fm + ((wgid % nig) % gsz); pn = (wgid % nig) / gsz; return true;
}

typedef int v8i __attribute__((ext_vector_type(8)));
typedef int v4i __attribute__((ext_vector_type(4)));
template <int N> __device__ __forceinline__ void wait_vm() { asm volatile("s_waitcnt vmcnt(%0)" :: "n"(N) : "memory"); }
template <class Epi, class Sched, bool ALIGN_EPI, bool SP2, bool F8 = false>
__device__ __forceinline__ void gemm_phase(LAS unsigned char* lds, const int wid_in, const int K, const int lda, const int ldb, const Sched& S, const Epi& E) {
    int lane_ = lane_id(); asm volatile("" : "+v"(lane_));
    const int lane = lane_, wid = wid_in, tid = wid * 64 + lane, wr = wid >> 2, wc = wid & 3, fr = lane & 15, fq = lane >> 4;
    const int nt = K / BK;
    int RA[2], CA[2];
    unsigned voffA[2], voffB[2][2];
#pragma unroll
    for (int i = 0; i < 2; ++i) { int R, C; stage_rc(tid * 16 + i * 8192, R, C);
        RA[i] = R; CA[i] = C; voffA[i] = (unsigned)(R * lda + C) * 2u;
#pragma unroll
        for (int h = 0; h < 2; ++h) { const int Rb = Epi::PERM ? (CW * (R >> 5) + CQ * ((R >> 2) & 3) + CB * h + 4 * ((R >> 4) & 1) + (R & 3)) : (R + HALF * h);
            voffB[h][i] = (unsigned)(Rb * ldb + C) * 2u; } }
    const size_t kstep = (size_t)(BK * 2);
    const size_t hstepA = (size_t)HALF * lda * 2;
    const unsigned ldsw = (unsigned)wid * 1024u;
    const int aoff = lds_byte(wr * 64 + fr, fq * 8), boff = lds_byte(wc * 32 + fr, fq * 8);
    const int a8o0 = lds_byte(wr * 64 + fr, 16 * fq + 8 * (fq >> 1)), a8o1 = lds_byte(wr * 64 + fr, 16 * fq + 8 * (1 - (fq >> 1)));
    const int b8o0 = lds_byte(wc * 32 + fr, 16 * fq + 8 * (fq >> 1)), b8o1 = lds_byte(wc * 32 + fr, 16 * fq + 8 * (1 - (fq >> 1)));
#define PG8_SA(b, h) (((b) * 2 + (h)) * HTB)
#define PG8_SB(b, h) ((4 + (b) * 2 + (h)) * HTB)
#define PG8_STAGE(bufoff, gbase, voff) do { _Pragma("unroll") for (int _i = 0; _i < 2; ++_i) \
        __builtin_amdgcn_global_load_lds((const unsigned*)((const char*)(gbase) + (voff)[_i]), (LAS unsigned*)(lds + (bufoff) + ldsw + _i * 8192), 16, 0, 0); } while (0)
#define PG8_STAGE_A(b, h, kptr, NX) do { if constexpr (Sched::GATHER) { unsigned _g[2]; _g[0] = (NX) ? gN[h][0] : gC[h][0]; _g[1] = (NX) ? gN[h][1] : gC[h][1]; PG8_STAGE(PG8_SA(b, h), kptr, _g); } \
        else { PG8_STAGE(PG8_SA(b, h), (kptr) + (h) * hstepA, voffA); } } while (0)
#define PG8_LD8(p0, p1) __builtin_shufflevector(*(const LAS v4i*)(p0), *(const LAS v4i*)(p1), 0, 1, 2, 3, 4, 5, 6, 7)
#define PG8_LDA(dst, b, h) do { _Pragma("unroll") for (int m = 0; m < 4; ++m) { if constexpr (F8) { dst##8[m] = PG8_LD8(lds + PG8_SA(b, h) + a8o0 + m * 2048, lds + PG8_SA(b, h) + a8o1 + m * 2048); } \
        else { _Pragma("unroll") for (int k = 0; k < 2; ++k) dst[m][k] = *(const LAS bf16x8*)(lds + PG8_SA(b, h) + aoff + m * 2048 + k * 1024); } } } while (0)
#define PG8_LDB(dst, b, h) do { _Pragma("unroll") for (int n = 0; n < 2; ++n) { if constexpr (F8) { dst##8[n] = PG8_LD8(lds + PG8_SB(b, h) + b8o0 + n * 2048, lds + PG8_SB(b, h) + b8o1 + n * 2048); } \
        else { _Pragma("unroll") for (int k = 0; k < 2; ++k) dst[n][k] = *(const LAS bf16x8*)(lds + PG8_SB(b, h) + boff + n * 2048 + k * 1024); } } } while (0)
#define PG8_MMA(ai, bj, At, Bt) do { __builtin_amdgcn_s_setprio(1); _Pragma("unroll") for (int m = 0; m < 4; ++m) _Pragma("unroll") for (int n = 0; n < 2; ++n) { \
        if constexpr (F8) { asm volatile("v_mfma_scale_f32_16x16x128_f8f6f4 %0, %1, %2, %0, %3, %3 op_sel_hi:[0,0,0]" : "+v"(acc[ai][bj][m][n]) : "v"(Bt##8[n]), "v"(At##8[m]), "v"(f8scale)); } \
        else { _Pragma("unroll") for (int k = 0; k < 2; ++k) acc[ai][bj][m][n] = __builtin_amdgcn_mfma_f32_16x16x32_bf16(Bt[n][k], At[m][k], acc[ai][bj][m][n], 0, 0, 0); } } __builtin_amdgcn_s_setprio(0); } while (0)
#define PG8_WAIT_V(n) asm volatile("s_waitcnt vmcnt(" #n ")" ::: "memory")
#define PG8_WAIT_L(n) asm volatile("s_waitcnt lgkmcnt(" #n ")" ::: "memory")
#define PG8_BAR __builtin_amdgcn_s_barrier()
#define PG8_SCHED __builtin_amdgcn_sched_barrier(0)
    typename Sched::U cur, nxt; int ui = 0;
    if (!S.next(0, cur)) return;
    LAS unsigned char* eslot = lds + EPI_SLOT_OFF;
    if constexpr (Epi::PREF) { if (wid == 0) E.prefetch(cur, eslot, lane); }
    unsigned gC[2][2] = {{0u, 0u}, {0u, 0u}}, gN[2][2] = {{0u, 0u}, {0u, 0u}};
    if constexpr (Sched::GATHER) {
#pragma unroll
        for (int h = 0; h < 2; ++h)
#pragma unroll
            for (int i = 0; i < 2; ++i) gC[h][i] = (S.arow(cur, RA[i] + HALF * h) * (unsigned)lda + (unsigned)CA[i]) * 2u;
    }
    f32x4 acc[2][2][4][2];
#pragma unroll
    for (int a = 0; a < 2; ++a)
#pragma unroll
        for (int b = 0; b < 2; ++b)
#pragma unroll
            for (int m = 0; m < 4; ++m)
#pragma unroll
                for (int n = 0; n < 2; ++n) acc[a][b][m][n] = (f32x4){0.f, 0.f, 0.f, 0.f};
    int f8scale = 0x7f7f7f7f; asm volatile("" : "+v"(f8scale));
    bf16x8 At[F8 ? 1 : 4][2], B0[F8 ? 1 : 2][2], B1[F8 ? 1 : 2][2];
    v8i At8[F8 ? 4 : 1], B08[F8 ? 2 : 1], B18[F8 ? 2 : 1];
    const char* cA = S.baseA(cur); const char* cB = S.baseB(cur);
    if constexpr (SP2) {
        PG8_STAGE(PG8_SB(0, 0), cB, voffB[0]); PG8_STAGE(PG8_SB(0, 1), cB, voffB[1]); PG8_STAGE_A(0, 0, cA, false); PG8_STAGE_A(0, 1, cA, false);
        if (wr == 1) PG8_BAR;
        PG8_WAIT_V(2); PG8_BAR;
        PG8_STAGE(PG8_SB(1, 0), cB + kstep, voffB[0]); PG8_STAGE_A(1, 0, cA + kstep, false); PG8_STAGE(PG8_SB(1, 1), cB + kstep, voffB[1]);
        PG8_WAIT_V(6); PG8_BAR;
    } else {
        PG8_STAGE(PG8_SB(0, 0), cB, voffB[0]); PG8_STAGE_A(0, 0, cA, false); PG8_STAGE(PG8_SB(0, 1), cB, voffB[1]); PG8_STAGE_A(0, 1, cA, false);
        if (wr == 1) PG8_BAR;
        PG8_WAIT_V(4); PG8_BAR;
        PG8_STAGE(PG8_SB(1, 0), cB + kstep, voffB[0]); PG8_STAGE_A(1, 0, cA + kstep, false); PG8_STAGE(PG8_SB(1, 1), cB + kstep, voffB[1]);
        PG8_WAIT_V(6); PG8_BAR;
    }
    for (;;) {
        const bool has_next = S.next(ui + 1, nxt);
        const char* nA = has_next ? S.baseA(nxt) : cA; const char* nB = has_next ? S.baseB(nxt) : cB;
        LAS unsigned char* gslot = lds + EPI_SLOT_OFF + 2 * EPI_SLOT_BYTES + ((ui + 1) & 1) * 1024;
        if constexpr (Sched::GATHER) { if (has_next && wid == 1) S.rows_dma(nxt, gslot, lane); }
#pragma unroll 1
        for (int t = 0; t < nt; t += 2) {
            const bool last = (t == nt - 2), seam = (t == 0) && (ui > 0);
            if constexpr (Sched::GATHER) { if (last) {
#pragma unroll
                for (int h = 0; h < 2; ++h)
#pragma unroll
                    for (int i = 0; i < 2; ++i) { int tid2 = tid; asm volatile("" : "+v"(tid2)); int R2, C2; stage_rc(tid2 * 16 + i * 8192, R2, C2);
                        const int r_ = R2 + HALF * h; const unsigned tokr = (has_next && r_ < nxt.nv) ? *(const LAS unsigned*)(gslot + 4 * r_) : 0u;
                        gN[h][i] = has_next ? (tokr * (unsigned)lda + (unsigned)C2) * 2u : gC[h][i]; } } }
            const char* a1 = cA + (size_t)(t + 1) * kstep;
            const char* a2 = last ? nA : cA + (size_t)(t + 2) * kstep; const char* b2 = last ? nB : cB + (size_t)(t + 2) * kstep;
            const char* a3 = a2 + kstep; const char* b3 = b2 + kstep;
            if constexpr (SP2) {
            PG8_LDB(B0, 0, 0); PG8_LDB(B1, 0, 1); PG8_SCHED; PG8_LDA(At, 0, 0); if (!seam) PG8_STAGE_A(1, 1, a1, false);
            if (seam) wait_vm<8 + Epi::NST>(); else PG8_WAIT_V(8); PG8_WAIT_L(0); PG8_BAR; PG8_MMA(0, 0, At, B0); PG8_MMA(0, 1, At, B1); PG8_BAR; PG8_SCHED;
            PG8_LDA(At, 0, 1); PG8_STAGE(PG8_SB(0, 0), b2, voffB[0]); PG8_STAGE(PG8_SB(0, 1), b2, voffB[1]); PG8_STAGE_A(0, 0, a2, last);
            if (seam) wait_vm<8 + Epi::NST>(); else PG8_WAIT_V(8); PG8_WAIT_L(0); PG8_BAR; PG8_MMA(1, 0, At, B0); PG8_MMA(1, 1, At, B1); PG8_BAR; PG8_SCHED;
            PG8_LDB(B0, 1, 0); PG8_LDB(B1, 1, 1); PG8_SCHED; PG8_LDA(At, 1, 0); PG8_STAGE_A(0, 1, a2, last);
            if (seam) wait_vm<8 + Epi::NST>(); else PG8_WAIT_V(8); PG8_WAIT_L(0); PG8_BAR; PG8_MMA(0, 0, At, B0); PG8_MMA(0, 1, At, B1); PG8_BAR; PG8_SCHED;
            PG8_LDA(At, 1, 1); PG8_STAGE(PG8_SB(1, 0), b3, voffB[0]); PG8_STAGE(PG8_SB(1, 1), b3, voffB[1]); PG8_STAGE_A(1, 0, a3, last);
            PG8_WAIT_V(8); PG8_WAIT_L(0); PG8_BAR; PG8_MMA(1, 0, At, B0); PG8_MMA(1, 1, At, B1); PG8_BAR; PG8_SCHED;
            } else {
            PG8_LDB(B0, 0, 0); PG8_SCHED; PG8_LDA(At, 0, 0); if (!seam) PG8_STAGE_A(1, 1, a1, false);
            PG8_WAIT_L(8); PG8_BAR; PG8_WAIT_L(0); PG8_MMA(0, 0, At, B0); PG8_BAR; PG8_SCHED;
            PG8_LDB(B1, 0, 1); PG8_STAGE(PG8_SB(0, 0), b2, voffB[0]);
            PG8_BAR; PG8_WAIT_L(0); PG8_MMA(0, 1, At, B1); PG8_BAR;
            PG8_LDA(At, 0, 1); PG8_STAGE_A(0, 0, a2, last);
            PG8_BAR; PG8_WAIT_L(0); PG8_MMA(1, 0, At, B0); PG8_BAR; PG8_SCHED;
            PG8_STAGE(PG8_SB(0, 1), b2, voffB[1]);
            if (seam) wait_vm<6 + Epi::NST>(); else PG8_WAIT_V(6); PG8_BAR; PG8_MMA(1, 1, At, B1); PG8_BAR;
            PG8_LDB(B0, 1, 0); PG8_SCHED; PG8_LDA(At, 1, 0); PG8_STAGE_A(0, 1, a2, last);
            PG8_WAIT_L(8); PG8_BAR; PG8_WAIT_L(0); PG8_MMA(0, 0, At, B0); PG8_BAR; PG8_SCHED;
            PG8_LDB(B1, 1, 1); PG8_STAGE(PG8_SB(1, 0), b3, voffB[0]);
            PG8_BAR; PG8_WAIT_L(0); PG8_MMA(0, 1, At, B1); PG8_BAR;
            PG8_LDA(At, 1, 1); PG8_STAGE_A(1, 0, a3, last);
            PG8_BAR; PG8_WAIT_L(0); PG8_MMA(1, 0, At, B0); PG8_BAR; PG8_SCHED;
            PG8_STAGE(PG8_SB(1, 1), b3, voffB[1]);
            PG8_WAIT_V(6); PG8_BAR; PG8_MMA(1, 1, At, B1); PG8_BAR;
            }
        }
        if (has_next) { PG8_STAGE_A(1, 1, nA + kstep, true); }
        if constexpr (ALIGN_EPI) { if (wr == 0) PG8_BAR; }
        { int fr2 = lane & 15, fq2 = lane >> 4; asm volatile("" : "+v"(fr2), "+v"(fq2));
          if constexpr (Epi::PREF) E(acc, cur, wr, wc, fr2, fq2, (const LAS unsigned char*)(eslot + (ui & 1) * EPI_SLOT_BYTES)); else E(acc, cur, wr, wc, fr2, fq2); }
        if (!has_next) break;
        if constexpr (!Epi::CHAIN) {
#pragma unroll
        for (int a = 0; a < 2; ++a)
#pragma unroll
            for (int b = 0; b < 2; ++b)
#pragma unroll
                for (int m = 0; m < 4; ++m)
#pragma unroll
                    for (int n = 0; n < 2; ++n) acc[a][b][m][n] = (f32x4){0.f, 0.f, 0.f, 0.f}; }
        cur = nxt; cA = nA; cB = nB; ++ui;
        if constexpr (Epi::PREF) { if (wid == 0) E.prefetch(cur, eslot + (ui & 1) * EPI_SLOT_BYTES, lane); }
        if constexpr (Sched::GATHER) {
#pragma unroll
            for (int h = 0; h < 2; ++h)
#pragma unroll
                for (int i = 0; i < 2; ++i) gC[h][i] = gN[h][i];
        }
        if constexpr (ALIGN_EPI) { if (wr == 1) PG8_BAR; }
    }
    PG8_WAIT_V(0);
    if constexpr (!ALIGN_EPI) { if (wr == 0) PG8_BAR; }
    PG8_BAR;
#undef PG8_SA
#undef PG8_SB
#undef PG8_STAGE
#undef PG8_STAGE_A
#undef PG8_LDA
#undef PG8_LDB
#undef PG8_MMA
#undef PG8_LD8
#undef PG8_WAIT_V
#undef PG8_WAIT_L
#undef PG8_BAR
#undef PG8_SCHED
}
}

struct TileU { int pm, pn; };
struct SchedDense {
    typedef TileU U; static constexpr bool GATHER = false;
    const char* A; const char* B; int nM, nN, G, c; size_t rsA, rsB;
    int reps = 1;
    __device__ __forceinline__ bool next(int i, U& u) const { const int nc = (nM * nN - c + G - 1) / G; if (i >= reps * nc) return false; return pg8::tile_order((long)(i % nc) * G + c, nM, nN, u.pm, u.pn); }
    __device__ __forceinline__ const char* baseA(const U& u) const { return A + (size_t)u.pm * rsA; }
    __device__ __forceinline__ const char* baseB(const U& u) const { return B + (size_t)u.pn * rsB; }
};
struct KvU { int pm, pn, vt; };
struct SchedKV {
    typedef KvU U; static constexpr bool GATHER = false;
    const char* memnb; const char* wkv; int c;
    __device__ __forceinline__ bool next(int i, U& u) const { if (i != 0 || c >= 64) return false; const int k = c & 31; u.vt = c >> 5; if (u.vt) { u.pm = k >> 3; u.pn = k & 7; } else { u.pm = k >> 2; u.pn = k & 3; } return true; }
    __device__ __forceinline__ const char* baseA(const U& u) const { return u.vt ? wkv + (size_t)(1024 + 256 * u.pm) * 1024 : memnb + (size_t)(256 * u.pm) * 1024; }
    __device__ __forceinline__ const char* baseB(const U& u) const { return u.vt ? memnb + (size_t)(256 * u.pn) * 1024 : wkv + (size_t)(256 * u.pn) * 1024; }
};
struct SchedAttn {
    typedef TileU U; static constexpr bool GATHER = false;
    const char* QP; const char* Bm; int pass, G, c;
    __device__ __forceinline__ bool next(int i, U& u) const { const int L = i * G + c; if (L >= 512) return false; u.pm = L >> 2; u.pn = L & 3; return true; }
    __device__ __forceinline__ const char* baseA(const U& u) const { return QP + ((size_t)u.pm * 256 * 1024 + (size_t)u.pn * 256); }
    __device__ __forceinline__ const char* baseB(const U& u) const { const int b = u.pm >> 4; return pass == 0 ? Bm + ((size_t)b * 256 * 1024 + (size_t)u.pn * 256) : Bm + ((size_t)u.pn * 256 * 2048 + (size_t)b * 256); }
};
struct MrgU { int pm, pn, br, j; };
struct SchedMerge {
    typedef MrgU U; static constexpr bool GATHER = false;
    const char* Y; const char* X; const char* W; int G, c;
    int reps = 1;
    __device__ __forceinline__ bool next(int i, U& u) const { const int nc = 3 * ((512 - c + G - 1) / G); if (i >= reps * nc) return false; const int ie = i % nc; const int j = ie / 3; u.j = j; u.br = ie - 3 * j; return pg8::tile_order((long)j * G + c, 128, 4, u.pm, u.pn); }
    __device__ __forceinline__ const char* baseA(const U& u) const { return (u.br == 2 ? X : Y + (size_t)u.br * (32 * MiB)) + (size_t)u.pm * 256 * 1024; }
    __device__ __forceinline__ const char* baseB(const U& u) const { return W + (size_t)u.br * MiB + (size_t)u.pn * 256 * 1024; }
};
struct MoeU { int pm, pn, e, nv; };
template <bool GATH> struct SchedMoe {
    typedef MoeU U; static constexpr bool GATHER = GATH;
    const char* A; const char* W; const int* perm; const LAS int* pref; const LAS int* cnt; int nN, G, c; size_t wstride; size_t tstep; int reps = 1;
    __device__ __forceinline__ bool next(int i, U& u) const {
        const int NT = pref[32]; const int nc = (NT * nN - c + G - 1) / G; if (i >= reps * nc) return false;
        if (!pg8::tile_order((long)(i % nc) * G + c, NT, nN, u.pm, u.pn)) return false;
        int e = -1;
        typedef int i32x4 __attribute__((ext_vector_type(4)));
        i32x4 pv[8];
#pragma unroll
        for (int j = 0; j < 8; ++j) pv[j] = ((const LAS i32x4*)pref)[j];
#pragma unroll
        for (int j = 0; j < 8; ++j) e += ((u.pm >= pv[j].x) ? 1 : 0) + ((u.pm >= pv[j].y) ? 1 : 0) + ((u.pm >= pv[j].z) ? 1 : 0) + ((u.pm >= pv[j].w) ? 1 : 0);
        u.e = __builtin_amdgcn_readfirstlane(e); const int r0 = (u.pm - pref[u.e]) * 256; int nv = cnt[u.e] - r0; u.nv = nv > 256 ? 256 : nv; return true;
    }
    __device__ __forceinline__ const char* baseA(const U& u) const { return GATH ? A : A + (size_t)u.pm * tstep; }
    __device__ __forceinline__ const char* baseB(const U& u) const { return W + (size_t)u.e * wstride + (size_t)u.pn * tstep; }
    __device__ __forceinline__ void rows_dma(const U& u, LAS unsigned char* dst, int lane) const {
        const int* src = perm + (size_t)u.e * 32768 + (size_t)(u.pm - pref[u.e]) * 256 + lane * 4;
        __builtin_amdgcn_global_load_lds((const unsigned*)src, (LAS unsigned*)dst, 16, 0, 0); }
    __device__ __forceinline__ unsigned arow(const U& u, int r) const { return (r < u.nv) ? (unsigned)perm[(size_t)u.e * 32768 + (size_t)(u.pm - pref[u.e]) * 256 + r] : 0u; }
};

struct EpiZ {
    static constexpr bool PERM = true; static constexpr bool PREF = true; static constexpr int NST = 8; static constexpr bool CHAIN = false;
    __device__ __forceinline__ void prefetch(const TileU& u, LAS unsigned char* slot, int lane) const {
        const int pn = u.pn + pn_off, grp = pn >> 2; if (grp < 6) return;
        __builtin_amdgcn_global_load_lds((const unsigned*)(b_gate + (grp - 6) * 1024 + (pn & 3) * 256 + lane * 4), (LAS unsigned*)slot, 16, 0, 0); }
    bf16_t* Z; const float* b_gate; int pn_off; float ascale; f32x2* gstat = nullptr;
    template <int MODE> __device__ __forceinline__ void run(const f32x4 (&acc)[2][2][4][2], bf16_t* base, const LAS float* bias, int row0, int col0, f32x2* stat = nullptr, int fq = 0) const {
        f32x4 bv[2][2];
#pragma unroll
        for (int bj = 0; bj < 2; ++bj)
#pragma unroll
            for (int n = 0; n < 2; ++n) bv[bj][n] = (MODE == 2) ? *(const LAS f32x4*)(bias + (col0 & 255) + bj * CB + 4 * n) * (-LOG2E) : (f32x4){0.f, 0.f, 0.f, 0.f};
#pragma unroll
        for (int ai = 0; ai < 2; ++ai)
#pragma unroll
            for (int m = 0; m < 4; ++m) { bf16_t* rowp = base + (size_t)(row0 + ai * 128 + m * 16) * D + col0; float s1 = 0.f, s2 = 0.f;
#pragma unroll
                for (int bj = 0; bj < 2; ++bj) { f32x4 v0 = acc[ai][bj][m][0], v1 = acc[ai][bj][m][1];
                    if (MODE == 1) {
#pragma unroll
                        for (int j = 0; j < 1; ++j) { v0 = gelu_tanh_4(v0); v1 = gelu_tanh_4(v1); }
                        if (stat) {
#pragma unroll
                            for (int j = 0; j < 4; ++j) { s1 += v0[j] + v1[j]; s2 += v0[j] * v0[j] + v1[j] * v1[j]; } } }
                    if (MODE == 2) { v0 = exp2_4(v0 * (-LOG2E * ascale) + bv[bj][0]); v1 = exp2_4(v1 * (-LOG2E * ascale) + bv[bj][1]);
                        v0 = rcp_4(v0 * (1.f / 255.f) + (1.f / 255.f)); v1 = rcp_4(v1 * (1.f / 255.f) + (1.f / 255.f));
#pragma unroll
                        for (int j = 0; j < 4; ++j) { v0[j] = fmaxf(v0[j], 1.0f); v1[j] = fmaxf(v1[j], 1.0f); }
                        u32x2 w8; w8.x = cvt4_u8(v0[0], v0[1], v0[2], v0[3]); w8.y = cvt4_u8(v1[0], v1[1], v1[2], v1[3]);
                        *(u32x2*)((unsigned char*)base + (size_t)(row0 + ai * 128 + m * 16) * D + col0 + bj * CB) = w8; continue; }
                    if (MODE == 3) { v0 *= ascale; v1 *= ascale; u32x2 w8; w8.x = cvt4_fp8(v0[0], v0[1], v0[2], v0[3]); w8.y = cvt4_fp8(v1[0], v1[1], v1[2], v1[3]);
                        *(u32x2*)((unsigned char*)base + (size_t)(row0 + ai * 128 + m * 16) * D + col0 + bj * CB) = w8; continue; }
                    u32x4 w; w.x = cvt_pk_bf16(v0[0], v0[1]); w.y = cvt_pk_bf16(v0[2], v0[3]); w.z = cvt_pk_bf16(v1[0], v1[1]); w.w = cvt_pk_bf16(v1[2], v1[3]);
                    *(u32x4*)(rowp + bj * CB) = w; }
                if (MODE == 1) { if (stat) { s1 += __shfl_xor(s1, 16); s1 += __shfl_xor(s1, 32); s2 += __shfl_xor(s2, 16); s2 += __shfl_xor(s2, 32);
                    if (fq == 0) stat[(size_t)(row0 + ai * 128 + m * 16) * 16] = (f32x2){s1, s2}; } } }
    }
    __device__ __forceinline__ void operator()(const f32x4 (&acc)[2][2][4][2], const TileU& u, int wr, int wc, int fr, int fq, const LAS unsigned char* slot) const {
        const int pn = u.pn + pn_off; const int grp = pn >> 2, colt = (pn & 3) * 256;
        const int row0 = u.pm * 256 + wr * 64 + fr;
        if (pn < 20) {
            if (pn >= 4 && pn < 12) {
                bf16_t* pb = Z + (size_t)1 * (ZSTRIDE / 2); const int j0 = (pn - 4) * 128 + wc * 32 + 8 * fq;
#pragma unroll
                for (int ai = 0; ai < 2; ++ai)
#pragma unroll
                    for (int m = 0; m < 4; ++m) { const f32x4 p0 = acc[ai][0][m][0] * acc[ai][1][m][0], p1 = acc[ai][0][m][1] * acc[ai][1][m][1];
                        u32x4 w; w.x = cvt_pk_bf16(p0[0], p0[1]); w.y = cvt_pk_bf16(p0[2], p0[3]); w.z = cvt_pk_bf16(p1[0], p1[1]); w.w = cvt_pk_bf16(p1[2], p1[3]);
                        *(u32x4*)(pb + (size_t)(row0 + ai * 128 + m * 16) * D + j0) = w; }
                return; }
            const int g2 = (pn < 4) ? 0 : (pn < 16 ? 3 : 4), c2 = ((pn < 4) ? pn : (pn < 16 ? pn - 12 : pn - 16)) * 256 + wc * CW + fq * CQ;
            bf16_t* b2 = Z + (size_t)g2 * (ZSTRIDE / 2);
            if (pn < 4) run<0>(acc, b2, nullptr, row0, c2);
            else if (pn < 16) run<1>(acc, b2, nullptr, row0, c2);
            else run<1>(acc, b2, nullptr, row0, c2, gstat + (pn - 16) * 4 + wc, fq);
            return; }
        bf16_t* base = Z + (size_t)grp * (ZSTRIDE / 2);
        const int col0 = colt + wc * CW + fq * CQ;
        if (grp == 5) run<3>(acc, base, nullptr, row0, col0);
        else run<2>(acc, base, (const LAS float*)slot, row0, col0);
    }
};
__device__ __forceinline__ void store_bf16_tile(const f32x4 (&acc)[2][2][4][2], bf16_t* O, size_t ldc, int row0, int col0) {
#pragma unroll
    for (int ai = 0; ai < 2; ++ai)
#pragma unroll
        for (int m = 0; m < 4; ++m) { bf16_t* rowp = O + (size_t)(row0 + ai * 128 + m * 16) * ldc + col0;
#pragma unroll
            for (int bj = 0; bj < 2; ++bj) { const f32x4 v0 = acc[ai][bj][m][0], v1 = acc[ai][bj][m][1];
                u32x4 w; w.x = cvt_pk_bf16(v0[0], v0[1]); w.y = cvt_pk_bf16(v0[2], v0[3]); w.z = cvt_pk_bf16(v1[0], v1[1]); w.w = cvt_pk_bf16(v1[2], v1[3]);
                *(u32x4*)(rowp + bj * CB) = w; } }
}
__device__ __forceinline__ void store_fp8_tile(const f32x4 (&acc)[2][2][4][2], unsigned char* O, size_t ldc, int row0, int col0, float scale) {
#pragma unroll
    for (int ai = 0; ai < 2; ++ai)
#pragma unroll
        for (int m = 0; m < 4; ++m) { unsigned char* rowp = O + (size_t)(row0 + ai * 128 + m * 16) * ldc + col0;
#pragma unroll
            for (int bj = 0; bj < 2; ++bj) { const f32x4 v0 = acc[ai][bj][m][0] * scale, v1 = acc[ai][bj][m][1] * scale;
                u32x2 w; w.x = cvt4_fp8(v0[0], v0[1], v0[2], v0[3]); w.y = cvt4_fp8(v1[0], v1[1], v1[2], v1[3]); *(u32x2*)(rowp + bj * CB) = w; } }
}
struct EpiKV {
    static constexpr bool PERM = true; static constexpr bool PREF = false; static constexpr int NST = 8; static constexpr bool CHAIN = false;
    unsigned char* Kmat; unsigned char* Vt;
    __device__ __forceinline__ void operator()(const f32x4 (&acc)[2][2][4][2], const KvU& u, int wr, int wc, int fr, int fq) const {
        const int row0 = u.pm * 256 + wr * 64 + fr, col0 = u.pn * 256 + wc * CW + fq * CQ;
        if (u.vt) store_fp8_tile(acc, Vt, 2048, row0, col0, W8_INV); else store_fp8_tile(acc, Kmat, 1024, row0, col0, W8_INV);
    }
};
struct EpiAttnS {
    static constexpr bool PERM = true; static constexpr bool PREF = false; static constexpr int NST = 8; static constexpr bool CHAIN = false;
    unsigned char* QP; LAS float* red;
    __device__ __forceinline__ void operator()(f32x4 (&acc)[2][2][4][2], const TileU& u, int wr, int wc, int fr, int fq) const {
        LAS float* rmax = red; LAS float* rsum = red + 1024;
#pragma unroll
        for (int ai = 0; ai < 2; ++ai)
#pragma unroll
            for (int bj = 0; bj < 2; ++bj)
#pragma unroll
                for (int m = 0; m < 4; ++m)
#pragma unroll
                    for (int n = 0; n < 2; ++n) acc[ai][bj][m][n] *= QSCALE;
#pragma unroll
        for (int ai = 0; ai < 2; ++ai)
#pragma unroll
            for (int m = 0; m < 4; ++m) { float mx = -3.0e38f;
#pragma unroll
                for (int bj = 0; bj < 2; ++bj)
#pragma unroll
                    for (int n = 0; n < 2; ++n) { const f32x4 x = acc[ai][bj][m][n]; mx = fmaxf(mx, fmaxf(fmaxf(x[0], x[1]), fmaxf(x[2], x[3]))); }
                mx = fmaxf(mx, __shfl_xor(mx, 16)); mx = fmaxf(mx, __shfl_xor(mx, 32));
                if (fq == 0) rmax[(ai * 128 + wr * 64 + m * 16 + fr) * 4 + wc] = mx; }
        asm volatile("s_waitcnt lgkmcnt(0)" ::: "memory"); __builtin_amdgcn_s_barrier(); asm volatile("" ::: "memory");
#pragma unroll
        for (int ai = 0; ai < 2; ++ai)
#pragma unroll
            for (int m = 0; m < 4; ++m) { const int r = ai * 128 + wr * 64 + m * 16 + fr; const f32x4 q = *(const LAS f32x4*)(rmax + r * 4);
                const float mx = fmaxf(fmaxf(q[0], q[1]), fmaxf(q[2], q[3])); float s = 0.f;
#pragma unroll
                for (int bj = 0; bj < 2; ++bj)
#pragma unroll
                    for (int n = 0; n < 2; ++n) { f32x4 x = acc[ai][bj][m][n];
#pragma unroll
                        for (int j = 0; j < 4; ++j) { x[j] = fast_exp2(x[j] - mx); s += x[j]; }
                        acc[ai][bj][m][n] = x; }
                s += __shfl_xor(s, 16); s += __shfl_xor(s, 32);
                if (fq == 0) rsum[r * 4 + wc] = s; }
        asm volatile("s_waitcnt lgkmcnt(0)" ::: "memory"); __builtin_amdgcn_s_barrier(); asm volatile("" ::: "memory");
        const int row0 = u.pm * 256 + wr * 64 + fr, col0 = u.pn * 256 + wc * CW + fq * CQ;
#pragma unroll
        for (int ai = 0; ai < 2; ++ai)
#pragma unroll
            for (int m = 0; m < 4; ++m) { const int r = ai * 128 + wr * 64 + m * 16 + fr; const f32x4 q = *(const LAS f32x4*)(rsum + r * 4);
                const float inv = 256.0f * fast_rcp((q[0] + q[1]) + (q[2] + q[3]));
                unsigned char* rowp = QP + (size_t)(row0 + ai * 128 + m * 16) * D + col0;
#pragma unroll
                for (int bj = 0; bj < 2; ++bj) { const f32x4 v0 = acc[ai][bj][m][0] * inv, v1 = acc[ai][bj][m][1] * inv;
                    u32x2 w; w.x = cvt4_fp8(v0[0], v0[1], v0[2], v0[3]); w.y = cvt4_fp8(v1[0], v1[1], v1[2], v1[3]);
                    *(u32x2*)(rowp + bj * CB) = w; } }
        asm volatile("s_waitcnt lgkmcnt(0)" ::: "memory"); __builtin_amdgcn_s_barrier(); asm volatile("" ::: "memory");
    }
};
struct EpiAttnO {
    static constexpr bool PERM = true; static constexpr bool PREF = false; static constexpr int NST = 8; static constexpr bool CHAIN = false;
    unsigned char* Y8;
    __device__ __forceinline__ void operator()(const f32x4 (&acc)[2][2][4][2], const TileU& u, int wr, int wc, int fr, int fq) const {
        const int row0 = u.pm * 256 + wr * 64 + fr, col0 = u.pn * 256 + wc * CW + fq * CQ;
#pragma unroll
        for (int ai = 0; ai < 2; ++ai)
#pragma unroll
            for (int m = 0; m < 4; ++m) { unsigned char* rowp = Y8 + (size_t)(row0 + ai * 128 + m * 16) * D + col0;
#pragma unroll
                for (int bj = 0; bj < 2; ++bj) { const f32x4 v0 = acc[ai][bj][m][0] * (1.0f / 256.0f), v1 = acc[ai][bj][m][1] * (1.0f / 256.0f);
                    u32x2 w; w.x = cvt4_fp8(v0[0], v0[1], v0[2], v0[3]); w.y = cvt4_fp8(v1[0], v1[1], v1[2], v1[3]); *(u32x2*)(rowp + bj * CB) = w; } }
    }
};
struct EpiMerge {
    static constexpr bool PERM = true; static constexpr bool PREF = false; static constexpr int NST = 16; static constexpr bool CHAIN = true;
    const bf16_t* Z; bf16_t* merged;
    __device__ __forceinline__ bool keep(const MrgU& u) const { return u.br != 2; }
    __device__ __forceinline__ void operator()(f32x4 (&acc)[2][2][4][2], const MrgU& u, int wr, int wc, int fr, int fq) const {
        const int row0 = u.pm * 256 + wr * 64 + fr, col0 = u.pn * 256 + wc * CW + fq * CQ;
        const bool lastb = u.br == 2;
        GAS const unsigned char* gp = (GAS const unsigned char*)Z + (size_t)(6 + u.br) * ZSTRIDE + (size_t)row0 * D + col0;
        GAS const unsigned char* hp = lastb ? gp : gp + ZSTRIDE;
        GAS bf16_t* mp = (GAS bf16_t*)merged + (size_t)row0 * D + col0;
        asm volatile("" : "+v"(gp), "+v"(hp), "+v"(mp));
        const float fin = W8_INV * (1.f / 255.f), keepf = lastb ? 0.f : 1.f;
        u32x4 gq[2][2], hq[2][2];
#define MRG_LOAD(buf_) do { gq[buf_][0] = *(GAS const u32x4*)gp; hq[buf_][0] = *(GAS const u32x4*)hp; gq[buf_][1] = *(GAS const u32x4*)(gp + 16 * D); hq[buf_][1] = *(GAS const u32x4*)(hp + 16 * D); } while (0)
        MRG_LOAD(0); gp += 32 * D; hp += 32 * D; asm volatile("" : "+v"(gp), "+v"(hp));
#pragma unroll
        for (int b = 0; b < 4; ++b) { const int ai = b >> 1, buf = b & 1;
            if (b < 3) { MRG_LOAD((b + 1) & 1); gp += (b == 0 ? 96 : 32) * D; hp += (b == 0 ? 96 : 32) * D; asm volatile("" : "+v"(gp), "+v"(hp)); }
#pragma unroll
            for (int r = 0; r < 2; ++r) { const int m = 2 * (b & 1) + r;
#pragma unroll
                for (int bj = 0; bj < 2; ++bj) { const unsigned gx = bj ? gq[buf][r].z : gq[buf][r].x, gy = bj ? gq[buf][r].w : gq[buf][r].y;
                    const unsigned hx = bj ? hq[buf][r].z : hq[buf][r].x, hy = bj ? hq[buf][r].w : hq[buf][r].y;
                    f32x4 s0 = {ub0(gx), ub1(gx), ub2(gx), ub3(gx)}, s1 = {ub0(gy), ub1(gy), ub2(gy), ub3(gy)};
                    if (lastb) { const f32x4 v0 = acc[ai][bj][m][0] * (s0 * fin), v1 = acc[ai][bj][m][1] * (s1 * fin);
                        u32x4 w; w.x = cvt_pk_bf16(v0[0], v0[1]); w.y = cvt_pk_bf16(v0[2], v0[3]); w.z = cvt_pk_bf16(v1[0], v1[1]); w.w = cvt_pk_bf16(v1[2], v1[3]);
                        *(GAS u32x4*)(mp + bj * CB) = w;
                        acc[ai][bj][m][0] *= keepf; acc[ai][bj][m][1] *= keepf; }
                    else { acc[ai][bj][m][0] *= s0 * rcp_4((f32x4){ub0(hx), ub1(hx), ub2(hx), ub3(hx)}); acc[ai][bj][m][1] *= s1 * rcp_4((f32x4){ub0(hy), ub1(hy), ub2(hy), ub3(hy)}); }
                    asm volatile("" : "+v"(acc[ai][bj][m][0]), "+v"(acc[ai][bj][m][1])); }
                mp += (size_t)((b == 1 && r == 1) ? 80 : 16) * D; asm volatile("" : "+v"(mp)); }
            asm volatile("" ::: "memory"); }
#undef MRG_LOAD
    }
};
struct EpiResid {
    static constexpr bool PERM = true; static constexpr bool PREF = false; static constexpr int NST = 16; static constexpr bool CHAIN = false;
    const bf16_t* x; bf16_t* out;
    __device__ __forceinline__ void operator()(const f32x4 (&acc)[2][2][4][2], const TileU& u, int wr, int wc, int fr, int fq) const {
        const int row0 = u.pm * 256 + wr * 64 + fr, col0 = u.pn * 256 + wc * CW + fq * CQ;
        GAS const bf16_t* xp = (GAS const bf16_t*)x + (size_t)row0 * D + col0; GAS bf16_t* op = (GAS bf16_t*)out + (size_t)row0 * D + col0;
        asm volatile("" : "+v"(xp), "+v"(op));
        u32x4 xq[2][4];
#define RES_LOAD(buf_) do { xq[buf_][0] = *(GAS const u32x4*)xp; xq[buf_][1] = *(GAS const u32x4*)(xp + CB); xq[buf_][2] = *(GAS const u32x4*)(xp + 16 * D); xq[buf_][3] = *(GAS const u32x4*)(xp + 16 * D + CB); } while (0)
        RES_LOAD(0); xp += 32 * D; asm volatile("" : "+v"(xp));
#pragma unroll
        for (int b = 0; b < 4; ++b) { const int ai = b >> 1, buf = b & 1;
            if (b < 3) { RES_LOAD((b + 1) & 1); xp += (b == 0 ? 96 : 32) * D; asm volatile("" : "+v"(xp)); }
#pragma unroll
            for (int r = 0; r < 2; ++r) { const int m = 2 * (b & 1) + r;
#pragma unroll
                for (int bj = 0; bj < 2; ++bj) { const u32x4 q = xq[buf][r * 2 + bj];
                    const f32x4 x0 = {bf_lo(q.x), bf_hi(q.x), bf_lo(q.y), bf_hi(q.y)}, x1 = {bf_lo(q.z), bf_hi(q.z), bf_lo(q.w), bf_hi(q.w)};
                    const f32x4 v0 = x0 * ALPHA + acc[ai][bj][m][0], v1 = x1 * ALPHA + acc[ai][bj][m][1];
                    u32x4 w; w.x = cvt_pk_bf16(v0[0], v0[1]); w.y = cvt_pk_bf16(v0[2], v0[3]); w.z = cvt_pk_bf16(v1[0], v1[1]); w.w = cvt_pk_bf16(v1[2], v1[3]);
                    *(GAS u32x4*)(op + bj * CB) = w; }
                op += (size_t)((b == 1 && r == 1) ? 80 : 16) * D; asm volatile("" : "+v"(op)); }
            asm volatile("" ::: "memory"); }
#undef RES_LOAD
    }
};
struct EpiAct {
    static constexpr bool PERM = true; static constexpr bool PREF = true; static constexpr int NST = 8; static constexpr bool CHAIN = false;
    __device__ __forceinline__ void prefetch(const MoeU& u, LAS unsigned char* slot, int lane) const {
        const float* src = bgu + (size_t)u.e * 2048 + u.pn * 128 + ((lane < 32) ? lane * 4 : 1024 + (lane - 32) * 4);
        __builtin_amdgcn_global_load_lds((const unsigned*)src, (LAS unsigned*)slot, 16, 0, 0); }
    unsigned char* act; const float* bgu;
    __device__ __forceinline__ void operator()(const f32x4 (&acc)[2][2][4][2], const MoeU& u, int wr, int wc, int fr, int fq, const LAS unsigned char* slot) const {
        const int row0 = u.pm * 256 + wr * 64 + fr, jl = wc * 32 + 8 * fq, j0 = u.pn * 128 + jl;
        const LAS float* bg = (const LAS float*)slot + jl; const LAS float* bu = bg + 128;
        f32x4 bgv[2], buv[2];
#pragma unroll
        for (int n = 0; n < 2; ++n) { bgv[n] = *(const LAS f32x4*)(bg + 4 * n); buv[n] = *(const LAS f32x4*)(bu + 4 * n) + 1.0f; }
#pragma unroll
        for (int ai = 0; ai < 2; ++ai)
#pragma unroll
            for (int m = 0; m < 4; ++m) { f32x4 o[2];
#pragma unroll
                for (int n = 0; n < 2; ++n) { const f32x4 g = acc[ai][0][m][n] * W8_INV + bgv[n], uu = acc[ai][1][m][n] * W8_INV + buv[n];
                    f32x4 gl, ul;
#pragma unroll
                    for (int j = 0; j < 4; ++j) { gl[j] = fminf(g[j], 7.0f); ul[j] = fminf(fmaxf(uu[j], -6.0f), 8.0f); }
                    o[n] = ul * (gl * rcp_4(exp2_4(gl * (-1.702f * LOG2E)) + 1.0f)); }
                u32x2 w; w.x = cvt4_fp8(o[0][0], o[0][1], o[0][2], o[0][3]); w.y = cvt4_fp8(o[1][0], o[1][1], o[1][2], o[1][3]);
                *(u32x2*)(act + (size_t)(row0 + ai * 128 + m * 16) * D + j0) = w; }
    }
};
struct EpiDown {
    static constexpr bool PERM = true; static constexpr bool PREF = true; static constexpr int NST = 8; static constexpr bool CHAIN = false;
    __device__ __forceinline__ void prefetch(const MoeU& u, LAS unsigned char* slot, int lane) const {
        __builtin_amdgcn_global_load_lds((const unsigned*)(bdn + (size_t)u.e * 1024 + u.pn * 256 + lane * 4), (LAS unsigned*)slot, 16, 0, 0); }
    unsigned char* eo; const float* bdn; const float* sgate; const LAS int* pref;
    __device__ __forceinline__ void operator()(const f32x4 (&acc)[2][2][4][2], const MoeU& u, int wr, int wc, int fr, int fq, const LAS unsigned char* slot) const {
        const int rl0 = wr * 64 + fr, row0 = u.pm * 256 + rl0, cl = wc * CW + fq * CQ, col0 = u.pn * 256 + cl;
        const LAS float* bd = (const LAS float*)slot + cl;
        f32x4 bv[2][2];
#pragma unroll
        for (int bj = 0; bj < 2; ++bj)
#pragma unroll
            for (int n = 0; n < 2; ++n) bv[bj][n] = *(const LAS f32x4*)(bd + bj * CB + 4 * n) * EO8_SCALE;
#pragma unroll
        for (int ai = 0; ai < 2; ++ai)
#pragma unroll
            for (int m = 0; m < 4; ++m) { unsigned char* rowp = eo + (size_t)(row0 + ai * 128 + m * 16) * D + col0;
#pragma unroll
                for (int bj = 0; bj < 2; ++bj) { const f32x4 v0 = acc[ai][bj][m][0] * (W8_INV * EO8_SCALE) + bv[bj][0], v1 = acc[ai][bj][m][1] * (W8_INV * EO8_SCALE) + bv[bj][1];
                    u32x2 w; w.x = cvt4_fp8(v0[0], v0[1], v0[2], v0[3]); w.y = cvt4_fp8(v1[0], v1[1], v1[2], v1[3]);
                    *(u32x2*)(rowp + bj * CB) = w; } }
    }
};

#define XB_TMO      128
#define XB_XCNT(j)  (256  + 64 * (j))
#define XB_XSUB(j)  (1280 + 64 * (j))
#define XB_XGEN(j)  (2304 + 64 * (j))
#define XB_TOP      3328
#define XB_TOPGEN   3392
#define XCD_BAR_WORDS 3456
#define XB_SPIN_CAP (1u << 20)
__device__ __forceinline__ unsigned xb_ld(unsigned* p)              { return __hip_atomic_load(p, __ATOMIC_RELAXED, __HIP_MEMORY_SCOPE_AGENT); }
__device__ __forceinline__ unsigned xb_add(unsigned* p, unsigned v) { return __hip_atomic_fetch_add(p, v, __ATOMIC_RELAXED, __HIP_MEMORY_SCOPE_AGENT); }
__device__ __forceinline__ unsigned xb_xcc_id() { return (unsigned)__builtin_amdgcn_s_getreg((3 << 11) | 20) & 0xFu; }
#define XB_SPIN(cond, bar) do { unsigned _sp = 0; while (cond) { __builtin_amdgcn_s_sleep(1); \
    if ((++_sp & 255u) == 0u) { if (xb_ld(&(bar)[XB_TMO])) break; if (_sp > XB_SPIN_CAP) { atomicAdd(&(bar)[XB_TMO], 1u); break; } } } } while (0)
struct XcdBarrier { unsigned* bar; unsigned x; volatile LAS unsigned* st; };
__device__ __forceinline__ XcdBarrier xcd_barrier_post(unsigned* bar, volatile LAS unsigned* st) {
    XcdBarrier b; b.bar = bar; b.x = xb_xcc_id(); b.st = st;
    if (threadIdx.x == 0) (void)xb_add(&bar[XB_XCNT(b.x)], 1u);
    return b;
}
__device__ __forceinline__ void xcd_barrier_complete(unsigned* bar, unsigned x, unsigned& nloc, unsigned& nx) {
    const unsigned G = gridDim.x * gridDim.y * gridDim.z;
    unsigned sum, cnt, mine, sp = 0u;
    for (;;) {
        sum = 0u; cnt = 0u; mine = 0u;
#pragma unroll
        for (unsigned j = 0; j < 16; ++j) { const unsigned c = xb_ld(&bar[XB_XCNT(j)]); sum += c; cnt += (c > 0u) ? 1u : 0u; mine = (j == x) ? c : mine; }
        if (sum == G) break;
        __builtin_amdgcn_s_sleep(1);
        if ((++sp & 255u) == 0u) { if (xb_ld(&bar[XB_TMO])) break; if (sp > XB_SPIN_CAP) { atomicAdd(&bar[XB_TMO], 1u); break; } }
    }
    nloc = mine > 0u ? mine : 1u; nx = cnt > 0u ? cnt : 1u;
}
__device__ __forceinline__ void xcd_barrier(const XcdBarrier& b) {
    asm volatile("s_waitcnt vmcnt(0)" ::: "memory");
    __syncthreads();
    if (threadIdx.x == 0) {
        unsigned* bar = b.bar;
        __builtin_amdgcn_s_waitcnt(0);
        unsigned nloc = b.st[0], nx = b.st[1];
        if (nloc == 0u) { xcd_barrier_complete(bar, b.x, nloc, nx); b.st[0] = nloc; b.st[1] = nx; }
        const unsigned old = xb_add(&bar[XB_XSUB(b.x)], 1u);
        const unsigned gen = old / nloc;
        if (old + 1u == (gen + 1u) * nloc) {
            __builtin_amdgcn_fence(__ATOMIC_RELEASE, "agent");
            asm volatile("s_waitcnt vmcnt(0)" ::: "memory");
            const unsigned og = xb_add(&bar[XB_TOP], 1u);
            const unsigned tg = og / nx;
            if (og + 1u == (tg + 1u) * nx) xb_add(&bar[XB_TOPGEN], 1u);
            else XB_SPIN(xb_ld(&bar[XB_TOPGEN]) == tg, bar);
            __builtin_amdgcn_fence(__ATOMIC_ACQUIRE, "agent");
            xb_add(&bar[XB_XGEN(b.x)], 1u);
            asm volatile("s_waitcnt vmcnt(0)" ::: "memory");
        } else {
            XB_SPIN(xb_ld(&bar[XB_XGEN(b.x)]) == gen, bar);
            __builtin_amdgcn_fence(__ATOMIC_ACQUIRE, "agent");
            asm volatile("s_waitcnt vmcnt(0)" ::: "memory");
        }
    }
    __syncthreads();
}

struct Args { const float* in[26]; float* out; unsigned char* ws; int ph_lo, ph_hi; };
enum { I_X = 0, I_MEM, I_WIN, I_BGATE, I_CONVW, I_GWS, I_GB, I_GLNG, I_GLNB, I_MLNG, I_MLNB, I_WKV, I_WCP, I_WGP, I_WXP, I_WOUT, I_LN1G, I_LN1B, I_WR, I_BR, I_WGU, I_BGU, I_WDN, I_BDN, I_LN2G, I_LN2B };

__device__ __forceinline__ void transpose_item(const float* W, int N, bf16_t* dst, int K, LAS float* scr, int lane, bool spread = false) {
#pragma unroll 8
    for (int i = 0; i < 32; ++i) { const int kk = 2 * i + (lane >> 5); scr[kk * 33 + (lane & 31)] = __builtin_nontemporal_load(W + (size_t)kk * N + (lane & 31)); }
    LDS_WAIT(); asm volatile("" ::: "memory");
    const int c = lane & 7;
#pragma unroll
    for (int j = 0; j < 4; ++j) { const int n = (lane >> 3) + 8 * j; const LAS float* s = scr + (8 * c) * 33 + n;
        u32x4 o; o.x = cvt_pk_bf16(s[0 * 33], s[1 * 33]); o.y = cvt_pk_bf16(s[2 * 33], s[3 * 33]); o.z = cvt_pk_bf16(s[4 * 33], s[5 * 33]); o.w = cvt_pk_bf16(s[6 * 33], s[7 * 33]);
        const int nr = spread ? ((n >> 3) * 16 + (n & 7)) : n; *(GAS u32x4*)(dst + (size_t)nr * K + 8 * c) = o; }
    LDS_WAIT(); asm volatile("" ::: "memory");
}
__device__ __forceinline__ void transpose_item_f8(const float* W, int N, unsigned char* dst, LAS float* scr, int lane, bool spread = false) {
#pragma unroll 8
    for (int i = 0; i < 64; ++i) { const int kk = 2 * i + (lane >> 5); scr[kk * 33 + (lane & 31)] = __builtin_nontemporal_load(W + (size_t)kk * N + (lane & 31)) * W8_SCALE; }
    LDS_WAIT(); asm volatile("" ::: "memory");
    const int c = lane & 7;
#pragma unroll
    for (int j = 0; j < 4; ++j) { const int n = (lane >> 3) + 8 * j; const LAS float* sp = scr + (16 * c) * 33 + n;
        u32x4 o; o.x = cvt4_fp8(sp[0 * 33], sp[1 * 33], sp[2 * 33], sp[3 * 33]); o.y = cvt4_fp8(sp[4 * 33], sp[5 * 33], sp[6 * 33], sp[7 * 33]);
        o.z = cvt4_fp8(sp[8 * 33], sp[9 * 33], sp[10 * 33], sp[11 * 33]); o.w = cvt4_fp8(sp[12 * 33], sp[13 * 33], sp[14 * 33], sp[15 * 33]);
        const int nr = spread ? ((n >> 3) * 16 + (n & 7)) : n; __builtin_nontemporal_store(o, (GAS u32x4*)(dst + (size_t)nr * 1024 + 16 * c)); }
    LDS_WAIT(); asm volatile("" ::: "memory");
}
__device__ __forceinline__ void ln_row_affine_f8(const float* xrow, const float* g, const float* b, unsigned char* orow, int lane) {
    const f32x4* xr = (const f32x4*)xrow + lane;
    f32x4 v[4]; float s = 0.f;
#pragma unroll
    for (int j = 0; j < 4; ++j) { v[j] = xr[64 * j]; s += (v[j].x + v[j].y) + (v[j].z + v[j].w); }
    const float mean = wave_sum(s) * (1.f / D); float s2 = 0.f;
#pragma unroll
    for (int j = 0; j < 4; ++j) { v[j] = v[j] - mean; s2 += (v[j].x * v[j].x + v[j].y * v[j].y) + (v[j].z * v[j].z + v[j].w * v[j].w); }
    const float rstd = 1.f / sqrtf(wave_sum(s2) * (1.f / D) + LN_EPS);
    unsigned* o8 = (unsigned*)orow + lane;
#pragma unroll
    for (int j = 0; j < 4; ++j) { const f32x4 gg = ((const f32x4*)g)[lane + 64 * j], bb = ((const f32x4*)b)[lane + 64 * j]; const f32x4 y = v[j] * rstd * gg + bb;
        o8[64 * j] = cvt4_fp8(y.x, y.y, y.z, y.w); }
}

constexpr int NPH = 9;
__global__ void __launch_bounds__(NTHR, 2) fwd(Args args) {
    extern __shared__ __attribute__((aligned(16))) unsigned char lds_raw[];
    LAS unsigned char* lds = (LAS unsigned char*)lds_raw;
    volatile LAS unsigned* MISC = (volatile LAS unsigned*)(lds + MISC_OFF);
    const int wave = __builtin_amdgcn_readfirstlane((int)threadIdx.x >> 6);
#define FRESH_IDS() int lane = lane_id(); asm volatile("" : "+v"(lane)); const int tid = wave * 64 + lane; (void)tid
    const int G = gridDim.x, bx = blockIdx.x;
    const int vcu = (G % 8 == 0) ? (bx % 8) * (G / 8) + bx / 8 : bx;
    unsigned char* ws = args.ws;
    unsigned* ctl = (unsigned*)(ws + WS_CTL);
    for (int u = threadIdx.x; u < (LDS_BYTES - MISC_OFF) / 4; u += NTHR) MISC[u] = 0u;
    __syncthreads();
    XcdBarrier bar; bar.bar = ctl + CW_BAR; bar.x = 0; bar.st = MISC;
    if (MK_N_LAUNCHES == 1) bar = xcd_barrier_post(ctl + CW_BAR, MISC);
#define GRID_BAR() do { if (MK_N_LAUNCHES == 1) xcd_barrier(bar); } while (0)
    const int lo = args.ph_lo, hi = args.ph_hi;
#ifndef PH_MASK
#define PH_MASK 0x1ff
#endif
#define IN(k) (((PH_MASK >> (k)) & 1) && lo <= (k) && (k) < hi)
#define BOTH(k) (IN(k) && IN((k) + 1))
    const int gw = vcu * NWAVES + wave, NGW = G * NWAVES;
    bf16_t* const Zb = (bf16_t*)(ws + WS_Z);

    if (IN(0)) {
        FRESH_IDS();
        LAS float* scr = (LAS float*)(lds + wave * 16896);
        constexpr int I_IN = 16 * 160, I_KV = 16 * 64, I_PJ = 16 * 32, I_GU = 8 * 64, I_DN = 8 * 32;
        constexpr int N0 = I_IN, N1 = N0, N2 = N1, N3 = N2 + I_PJ, N4 = N3 + 32 * I_GU, N5 = N4 + 32 * I_DN;
        constexpr int I_IN8 = 8 * 128, I_WX8 = 8 * 32, N6 = N5 + I_IN8, N7 = N6 + 3 * I_WX8, N8E = N7 + 8 * 64;
        for (int it = gw; it < N8E; it += NGW) {
            if (it >= N5) {
                int r8 = it - N5, N8 = NZ, nb8 = 128; const float* src = args.in[I_WIN] + 5120; unsigned char* dbase = ws + WS_WIN8;
                if (it >= N7) { r8 = it - N7; N8 = 2048; nb8 = 64; src = args.in[I_WKV]; dbase = ws + WS_WKV; }
                else if (it >= N6) { r8 = it - N6; const int br = r8 / I_WX8; r8 -= br * I_WX8; N8 = 1024; nb8 = 32; src = args.in[I_WCP + br]; dbase = ws + WS_WP8 + (size_t)br * MiB; }
                const int kb = r8 / nb8, nb = r8 - kb * nb8, k0 = 128 * kb, n0 = 32 * nb;
                const float* W8 = src + (size_t)k0 * N8 + n0;
                unsigned char* d8 = dbase + (size_t)n0 * 1024 + k0;
                transpose_item_f8(W8, N8, d8, scr, lane); continue; }
            if (it >= N3) {
                int r8 = it - N3; const bool dn = r8 >= 32 * I_GU; if (dn) r8 -= 32 * I_GU; const int per = dn ? I_DN : I_GU, e = r8 / per; r8 -= e * per;
                const int N8 = dn ? 1024 : 2048, nb8 = N8 / 32, kb = r8 / nb8, nb = r8 - kb * nb8, k0 = 128 * kb, n0 = 32 * nb; int drow = n0;
                if (!dn) { const int j0 = n0 & 1023; drow = (j0 >> 7) * 256 + ((j0 & 127) >> 3) * 16 + (n0 >> 10) * 8; }
                const float* W8 = (dn ? args.in[I_WDN] + (size_t)e * 1024 * 1024 : args.in[I_WGU] + (size_t)e * 1024 * 2048) + (size_t)k0 * N8 + n0;
                unsigned char* d8 = (dn ? ws + WS_WDN + (size_t)e * 1024 * 1024 : ws + WS_WGU + (size_t)e * 2048 * 1024) + (size_t)drow * 1024 + k0;
                transpose_item_f8(W8, N8, d8, scr, lane, !dn); continue; }
            const float* W; int N, nblk, r; bf16_t* dst; int kind;
            if (it < N0) { r = it; W = args.in[I_WIN]; N = NZ; dst = (bf16_t*)(ws + WS_WIN); kind = 2; }
            else if (it < N3) { r = it - N2; W = args.in[I_WOUT]; N = 1024; dst = (bf16_t*)(ws + WS_WOUT); kind = 0; }
            else if (it < N4) { r = it - N3; const int e = r / I_GU; r -= e * I_GU; W = args.in[I_WGU] + (size_t)e * 1024 * 2048; N = 2048; dst = (bf16_t*)(ws + WS_WGU) + (size_t)e * 2048 * 1024; kind = 1; }
            else { r = it - N4; const int e = r / I_DN; r -= e * I_DN; W = args.in[I_WDN] + (size_t)e * 1024 * 1024; N = 1024; dst = (bf16_t*)(ws + WS_WDN) + (size_t)e * 1024 * 1024; kind = 0; }
            nblk = (kind == 2) ? 160 : N / 32; const int kb = r / nblk, nb = r - kb * nblk, k0 = 64 * kb, n0 = 32 * nb;
            int drow = n0; bool spr = false;
            if (kind == 2 && n0 >= 1024 && n0 < 3072) { const int j0 = (n0 - 1024) & 1023, hf = (n0 - 1024) >> 10; drow = 1024 + (j0 >> 7) * 256 + ((j0 & 127) >> 3) * 16 + hf * 8; spr = true; }
            transpose_item(W + (size_t)k0 * N + n0, N, dst + (size_t)drow * 1024 + k0, 1024, scr, lane, spr);
        }
        { const f32x4* xs = (const f32x4*)args.in[I_X]; u32x4* xd = (u32x4*)(ws + WS_XB);
          for (size_t i = (size_t)gw * 64 + lane; i < (size_t)T * D / 8; i += (size_t)NGW * 64) { const f32x4 a = __builtin_nontemporal_load(xs + 2 * i), b = __builtin_nontemporal_load(xs + 2 * i + 1);
              u32x4 w; w.x = cvt_pk_bf16(a.x, a.y); w.y = cvt_pk_bf16(a.z, a.w); w.z = cvt_pk_bf16(b.x, b.y); w.w = cvt_pk_bf16(b.z, b.w); xd[i] = w;
              u32x2 q8; q8.x = cvt4_fp8(a.x, a.y, a.z, a.w); q8.y = cvt4_fp8(b.x, b.y, b.z, b.w); ((u32x2*)(ws + WS_X8))[i] = q8; } }
        for (int m = gw; m < MEMR; m += NGW) ln_row_affine_f8(args.in[I_MEM] + (size_t)m * D, args.in[I_MLNG], args.in[I_MLNB], ws + WS_MEMNB + (size_t)m * D, lane);
        { bf16_t* wt = (bf16_t*)(ws + WS_WTRIL); const float* gs = args.in[I_GWS];
          for (int i = gw * 64 + lane; i < 8 * 128 * 128; i += NGW * 64) { const int tt = (i >> 7) & 127, s = i & 127; const float v = (s <= tt) ? gs[i] : 0.f; wt[i] = (bf16_t)(cvt_pk_bf16(v, 0.f) & 0xffffu); } }
        { bf16_t* wh = (bf16_t*)(ws + WS_WRHI); bf16_t* wl = (bf16_t*)(ws + WS_WRLO); const float* wrp = args.in[I_WR];
          for (int i = gw * 64 + lane; i < 32 * 1024; i += NGW * 64) { const int e = i >> 10, k = i & 1023; const float v = wrp[k * 32 + e];
              const unsigned h = cvt_pk_bf16(v, 0.f) & 0xffffu; const float r = v - __uint_as_float(h << 16); wh[i] = (bf16_t)h; wl[i] = (bf16_t)(cvt_pk_bf16(r, 0.f) & 0xffffu); } }
        if (BOTH(0)) GRID_BAR();
    }

    if (IN(1)) {
        { SchedKV S{(const char*)(ws + WS_MEMNB), (const char*)(ws + WS_WKV), bx};
          EpiKV E{ws + WS_KMAT, ws + WS_VT};
          pg8::gemm_phase<EpiKV, SchedKV, false, PG8_SP2, true>(lds, wave, 512, 512, 512, S, E); }
        { SchedDense S{(const char*)(ws + WS_XB), (const char*)(ws + WS_WIN), T / 256, 20, G, bx, (size_t)256 * 2048, (size_t)256 * 2048};
          S.reps = (DUP_PHASE == 1) ? 2 : 1; EpiZ E{Zb, args.in[I_BGATE], 0, 1.0f, (f32x2*)(ws + WS_GSTAT)};
          pg8::gemm_phase<EpiZ, SchedDense, true, PG8_SP2>(lds, wave, 1024, 1024, 1024, S, E); }
        { SchedDense S{(const char*)(ws + WS_X8), (const char*)(ws + WS_WIN8), T / 256, 16, G, bx, (size_t)256 * 1024, (size_t)256 * 1024};
          S.reps = (DUP_PHASE == 1) ? 2 : 1; EpiZ E{Zb, args.in[I_BGATE], 20, W8_INV};
          pg8::gemm_phase<EpiZ, SchedDense, true, PG8_SP2, true>(lds, wave, 512, 512, 512, S, E); }
        if (BOTH(1)) GRID_BAR();
    }

    if (IN(2)) {
        FRESH_IDS();
#ifndef P2_SUB
#define P2_SUB 7
#endif
        if (P2_SUB & 1) {
            const bf16_t* pp = Zb + (size_t)1 * (ZSTRIDE / 2); const bf16_t* cb = Zb; unsigned char* yc8 = ws + WS_YB8;
            const float* cw = args.in[I_CONVW];
            for (int it = gw; it < (T / 16) * 2; it += NGW) {
                const int rb = it >> 1, c0 = (it & 1) * 512 + lane * 8, m0 = rb * 16, t0 = m0 & (SEQ - 1);
                float w0[8], w1[8], w2[8], p1[8], p2[8];
#pragma unroll
                for (int j = 0; j < 8; ++j) { w0[j] = cw[c0 + j]; w1[j] = cw[1024 + c0 + j]; w2[j] = cw[2048 + c0 + j]; p1[j] = 0.f; p2[j] = 0.f; }
                if (t0 >= 2) {
                    const u32x4 a1 = *(const u32x4*)(pp + (size_t)(m0 - 1) * D + c0), a2 = *(const u32x4*)(pp + (size_t)(m0 - 2) * D + c0);
                    p1[0] = bf_lo(a1.x); p1[1] = bf_hi(a1.x); p1[2] = bf_lo(a1.y); p1[3] = bf_hi(a1.y); p1[4] = bf_lo(a1.z); p1[5] = bf_hi(a1.z); p1[6] = bf_lo(a1.w); p1[7] = bf_hi(a1.w);
                    p2[0] = bf_lo(a2.x); p2[1] = bf_hi(a2.x); p2[2] = bf_lo(a2.y); p2[3] = bf_hi(a2.y); p2[4] = bf_lo(a2.z); p2[5] = bf_hi(a2.z); p2[6] = bf_lo(a2.w); p2[7] = bf_hi(a2.w);
                }
#pragma unroll 4
                for (int r = 0; r < 16; ++r) {
                    const size_t o = (size_t)(m0 + r) * D + c0;
                    const u32x4 a = *(const u32x4*)(pp + o), bq = *(const u32x4*)(cb + o);
                    float p0[8], bb[8], y[8];
                    p0[0] = bf_lo(a.x); p0[1] = bf_hi(a.x); p0[2] = bf_lo(a.y); p0[3] = bf_hi(a.y); p0[4] = bf_lo(a.z); p0[5] = bf_hi(a.z); p0[6] = bf_lo(a.w); p0[7] = bf_hi(a.w);
                    bb[0] = bf_lo(bq.x); bb[1] = bf_hi(bq.x); bb[2] = bf_lo(bq.y); bb[3] = bf_hi(bq.y); bb[4] = bf_lo(bq.z); bb[5] = bf_hi(bq.z); bb[6] = bf_lo(bq.w); bb[7] = bf_hi(bq.w);
#pragma unroll
                    for (int j = 0; j < 8; ++j) { y[j] = bb[j] * (w0[j] * p2[j] + w1[j] * p1[j] + w2[j] * p0[j]); p2[j] = p1[j]; p1[j] = p0[j]; }
#pragma unroll
                    for (int j = 0; j < 8; ++j) y[j] = fminf(fmaxf(y[j], -448.f), 448.f);
                    u32x2 w; w.x = cvt4_fp8(y[0], y[1], y[2], y[3]); w.y = cvt4_fp8(y[4], y[5], y[6], y[7]);
                    *(u32x2*)(yc8 + o) = w;
                }
            }
        }
        if (P2_SUB & 2) {
            const bf16_t* gu = Zb + (size_t)3 * (ZSTRIDE / 2); const bf16_t* gv = Zb + (size_t)4 * (ZSTRIDE / 2); unsigned char* yg8 = ws + WS_YB8 + 32 * MiB;
            const bf16_t* wtril = (const bf16_t*)(ws + WS_WTRIL);
            const float* lng = args.in[I_GLNG]; const float* lnb = args.in[I_GLNB]; const float* gbias = args.in[I_GB];
            LAS float* stat = (LAS float*)(lds);
            constexpr int VT_ROW = 136;
            LAS bf16_t* vT0 = (LAS bf16_t*)(lds + 2048);
            for (int ch = vcu; ch < T / 128; ch += G) {
                const int m0 = ch * 128;
                __syncthreads();
                if (lane < 16) { const int r = wave * 16 + lane; const f32x4* sp = (const f32x4*)((const f32x2*)(ws + WS_GSTAT) + (size_t)(m0 + r) * 16); float s1 = 0.f, s2 = 0.f;
#pragma unroll
                    for (int j = 0; j < 8; ++j) { const f32x4 q = sp[j]; s1 += q.x + q.z; s2 += q.y + q.w; }
                    const float mean = s1 * (1.f / D), var = fmaxf(s2 * (1.f / D) - mean * mean, 0.f);
                    stat[2 * r] = mean; stat[2 * r + 1] = 1.f / sqrtf(var + LN_EPS); }
                const int fi = lane & 15, fq = lane >> 4, tt = wave * 16 + fi; const int nks = (wave * 16 + 15) / 32 + 1;
                u32x4 av[4];
#pragma unroll
                for (int q = 0; q < 4; ++q) { const int c8 = wave * 2 + (q & 1), sr = (q >> 1) * 64 + lane; av[q] = *(const u32x4*)(gv + (size_t)(m0 + sr) * D + c8 * 8); }
                __syncthreads();
                for (int g = 0; g < 8; ++g) {
                    LAS bf16_t* vT = vT0 + (g & 1) * (128 * VT_ROW);
#pragma unroll
                    for (int q = 0; q < 4; ++q) {
                        const int c8 = wave * 2 + (q & 1), sr = (q >> 1) * 64 + lane, cg = g * 128 + c8 * 8;
                        const u32x4 a = av[q];
                        const float mean = stat[2 * sr], rstd = stat[2 * sr + 1];
                        const f32x4 g0 = *(const f32x4*)(lng + cg), g1 = *(const f32x4*)(lng + cg + 4), b0 = *(const f32x4*)(lnb + cg), b1 = *(const f32x4*)(lnb + cg + 4);
                        float v[8]; v[0] = bf_lo(a.x); v[1] = bf_hi(a.x); v[2] = bf_lo(a.y); v[3] = bf_hi(a.y); v[4] = bf_lo(a.z); v[5] = bf_hi(a.z); v[6] = bf_lo(a.w); v[7] = bf_hi(a.w);
#pragma unroll
                        for (int j = 0; j < 8; ++j) { const float gg = j < 4 ? g0[j & 3] : g1[j & 3], bb = j < 4 ? b0[j & 3] : b1[j & 3]; const float y = (v[j] - mean) * rstd * gg + bb;
                            vT[((2 * (c8 >> 2) + (j >> 2)) * 16 + 4 * (c8 & 3) + (j & 3)) * VT_ROW + sr] = (bf16_t)(cvt_pk_bf16(y, 0.f) & 0xffffu); }
                    }
                    if (g < 7) {
#pragma unroll
                        for (int q = 0; q < 4; ++q) { const int c8 = wave * 2 + (q & 1), sr = (q >> 1) * 64 + lane; av[q] = *(const u32x4*)(gv + (size_t)(m0 + sr) * D + (g + 1) * 128 + c8 * 8); } }
                    const size_t uo = (size_t)(m0 + tt) * D + g * 128 + 8 * fq;
                    u32x4 uu[4];
#pragma unroll
                    for (int k = 0; k < 4; ++k) uu[k] = *(const u32x4*)(gu + uo + k * 32);
                    const float bs = gbias[g * 128 + tt];
                    __syncthreads();
                    f32x4 acc[8];
#pragma unroll
                    for (int n = 0; n < 8; ++n) acc[n] = (f32x4){0.f, 0.f, 0.f, 0.f};
                    const bf16_t* wrow = wtril + ((size_t)g * 128 + wave * 16 + fi) * 128 + fq * 8;
                    for (int ks = 0; ks < nks; ++ks) {
                        const bf16x8 bfrag = *(const bf16x8*)(wrow + ks * 32);
#pragma unroll
                        for (int n = 0; n < 8; ++n) { const bf16x8 afrag = *(const LAS bf16x8*)(vT + (n * 16 + fi) * VT_ROW + ks * 32 + fq * 8);
                            acc[n] = __builtin_amdgcn_mfma_f32_16x16x32_bf16(afrag, bfrag, acc[n], 0, 0, 0); }
                    }
#pragma unroll
                    for (int k = 0; k < 4; ++k) { const u32x4 u4 = uu[k]; const f32x4 a0 = acc[2 * k] + bs, a1 = acc[2 * k + 1] + bs;
                        f32x4 y0 = {bf_lo(u4.x) * a0[0], bf_hi(u4.x) * a0[1], bf_lo(u4.y) * a0[2], bf_hi(u4.y) * a0[3]}, y1 = {bf_lo(u4.z) * a1[0], bf_hi(u4.z) * a1[1], bf_lo(u4.w) * a1[2], bf_hi(u4.w) * a1[3]};
#pragma unroll
                        for (int j = 0; j < 4; ++j) { y0[j] = fminf(fmaxf(y0[j], -448.f), 448.f); y1[j] = fminf(fmaxf(y1[j], -448.f), 448.f); }
                        u32x2 w; w.x = cvt4_fp8(y0[0], y0[1], y0[2], y0[3]); w.y = cvt4_fp8(y1[0], y1[1], y1[2], y1[3]); *(u32x2*)(yg8 + uo + k * 32) = w; }
                }
            }
            __syncthreads();
        }
        if (P2_SUB & 4) {
            bf16_t* qp = Zb + (size_t)5 * (ZSTRIDE / 2);
            { SchedAttn S{(const char*)qp, (const char*)(ws + WS_KMAT), 0, G, bx};
              EpiAttnS E{(unsigned char*)qp, (LAS float*)(lds + EPI_OFF)};
              pg8::gemm_phase<EpiAttnS, SchedAttn, true, false, true>(lds, wave, 128, 512, 512, S, E); }
            VM_WAIT(); __syncthreads();
            { SchedAttn S{(const char*)qp, (const char*)(ws + WS_VT), 1, G, bx};
              EpiAttnO E{ws + WS_X8};
              pg8::gemm_phase<EpiAttnO, SchedAttn, true, false, true>(lds, wave, 128, 512, 1024, S, E); }
        }
        if (BOTH(2)) GRID_BAR();
    }

    if (IN(3)) {
        { SchedMerge S{(const char*)(ws + WS_YB8), (const char*)(ws + WS_X8), (const char*)(ws + WS_WP8), G, bx};
          S.reps = (DUP_PHASE == 3) ? 2 : 1; EpiMerge E{Zb, (bf16_t*)(ws + WS_MERGED)};
          pg8::gemm_phase<EpiMerge, SchedMerge, true, PG8_SP2, true>(lds, wave, 512, 512, 512, S, E); }
        if (BOTH(3)) GRID_BAR();
    }

    if (IN(4)) {
        SchedDense S{(const char*)(ws + WS_MERGED), (const char*)(ws + WS_WOUT), T / 256, 4, G, bx, (size_t)256 * 2048, (size_t)256 * 2048};
        S.reps = (DUP_PHASE == 4) ? 2 : 1; EpiResid E{(const bf16_t*)(ws + WS_XB), (bf16_t*)(ws + WS_X1H)};
        pg8::gemm_phase<EpiResid, SchedDense, true, PG8_SP2>(lds, wave, 1024, 1024, 1024, S, E);
        if (BOTH(4)) GRID_BAR();
    }

    if (IN(5)) {
        FRESH_IDS();
        LAS float* lgs = (LAS float*)(lds) + wave * 512;
        volatile LAS unsigned* lcnt = MISC + 96; volatile LAS unsigned* lbase = MISC + 128;
        const bf16_t* wh = (const bf16_t*)(ws + WS_WRHI); const bf16_t* wl = (const bf16_t*)(ws + WS_WRLO);
        unsigned char* x1q = ws + WS_X1B;
        const float* g1 = args.in[I_LN1G]; const float* b1 = args.in[I_LN1B]; const float* brt = args.in[I_BR];
        int* perm = (int*)(ws + WS_PERM); float* sgate = (float*)(ws + WS_SGATE); unsigned* tok = (unsigned*)(ws + WS_TOK);
        const int nblk = T / 16, niter = (nblk + NGW - 1) / NGW;
        for (int itn = 0; itn < niter; ++itn) {
            const int rb = itn * NGW + gw; const bool active = rb < nblk; const int m0 = rb * 16;
            if (tid < 32) lcnt[tid] = 0u;
            __syncthreads();
            int se[4] = {0, 0, 0, 0}; unsigned sl[4] = {0u, 0u, 0u, 0u}; float sg[4] = {0.f, 0.f, 0.f, 0.f};
            if (active) {
                bf16_t* x1h = (bf16_t*)(ws + WS_X1H);
                f32x4 ga[2], gb[2], ba[2], bb[2];
#pragma unroll
                for (int j = 0; j < 2; ++j) { ga[j] = ((const f32x4*)g1)[2 * lane + 128 * j]; gb[j] = ((const f32x4*)g1)[2 * lane + 128 * j + 1]; ba[j] = ((const f32x4*)b1)[2 * lane + 128 * j]; bb[j] = ((const f32x4*)b1)[2 * lane + 128 * j + 1]; }
                for (int r0 = 0; r0 < 16; r0 += 4) {
                    u32x4 q[4][2];
#pragma unroll
                    for (int h = 0; h < 4; ++h)
#pragma unroll
                        for (int j = 0; j < 2; ++j) q[h][j] = ((const u32x4*)(x1h + (size_t)(m0 + r0 + h) * D) + lane)[64 * j];
#pragma unroll
                    for (int h = 0; h < 4; ++h) { const int r = r0 + h;
                        u32x4* xr = (u32x4*)(x1h + (size_t)(m0 + r) * D) + lane;
                        float v[16]; float s = 0.f;
#pragma unroll
                        for (int j = 0; j < 2; ++j) { const u32x4 qq = q[h][j]; v[8 * j + 0] = bf_lo(qq.x); v[8 * j + 1] = bf_hi(qq.x); v[8 * j + 2] = bf_lo(qq.y); v[8 * j + 3] = bf_hi(qq.y);
                            v[8 * j + 4] = bf_lo(qq.z); v[8 * j + 5] = bf_hi(qq.z); v[8 * j + 6] = bf_lo(qq.w); v[8 * j + 7] = bf_hi(qq.w); }
#pragma unroll
                        for (int j = 0; j < 16; ++j) s += v[j];
                        const float mean = wave_sum(s) * (1.f / D); float s2 = 0.f;
#pragma unroll
                        for (int j = 0; j < 16; ++j) { v[j] -= mean; s2 += v[j] * v[j]; }
                        const float rstd = 1.f / sqrtf(wave_sum(s2) * (1.f / D) + LN_EPS);
                        u32x2* o8 = (u32x2*)(x1q + (size_t)(m0 + r) * D) + lane;
#pragma unroll
                        for (int j = 0; j < 2; ++j) { float y[8];
#pragma unroll
                            for (int i = 0; i < 4; ++i) { y[i] = v[8 * j + i] * rstd * ga[j][i] + ba[j][i]; y[4 + i] = v[8 * j + 4 + i] * rstd * gb[j][i] + bb[j][i]; }
                            u32x4 w; w.x = cvt_pk_bf16(y[0], y[1]); w.y = cvt_pk_bf16(y[2], y[3]); w.z = cvt_pk_bf16(y[4], y[5]); w.w = cvt_pk_bf16(y[6], y[7]); xr[64 * j] = w;
                            u32x2 q8; q8.x = cvt4_fp8(y[0], y[1], y[2], y[3]); q8.y = cvt4_fp8(y[4], y[5], y[6], y[7]); o8[64 * j] = q8; } }
                }
                VM_WAIT();
                const int fi = lane & 15, fq = lane >> 4;
                f32x4 la[2] = {(f32x4){0.f, 0.f, 0.f, 0.f}, (f32x4){0.f, 0.f, 0.f, 0.f}};
                const bf16_t* xrow = x1h + (size_t)(m0 + fi) * D + fq * 8;
                const bf16_t* whr = wh + (size_t)fi * 1024 + fq * 8; const bf16_t* wlr = wl + (size_t)fi * 1024 + fq * 8;
#pragma unroll 4
                for (int s = 0; s < 32; ++s) {
                    const bf16x8 ah = *(const bf16x8*)(xrow + s * 32);
#pragma unroll
                    for (int n = 0; n < 2; ++n) { const bf16x8 bh = *(const bf16x8*)(whr + (size_t)n * 16 * 1024 + s * 32), bl = *(const bf16x8*)(wlr + (size_t)n * 16 * 1024 + s * 32);
                        la[n] = __builtin_amdgcn_mfma_f32_16x16x32_bf16(ah, bh, la[n], 0, 0, 0);
                        la[n] = __builtin_amdgcn_mfma_f32_16x16x32_bf16(ah, bl, la[n], 0, 0, 0); }
                }
#pragma unroll
                for (int n = 0; n < 2; ++n)
#pragma unroll
                    for (int r = 0; r < 4; ++r) lgs[(4 * fq + r) * 32 + 16 * n + fi] = la[n][r];
                LDS_WAIT(); asm volatile("" ::: "memory");
                if (lane < 16) {
                    float lv[32];
#pragma unroll
                    for (int e = 0; e < 32; ++e) lv[e] = lgs[lane * 32 + e] + brt[e];
                    float tv[4];
#pragma unroll
                    for (int k = 0; k < 4; ++k) { float best = -3.0e38f; int bi = 0;
#pragma unroll
                        for (int e = 0; e < 32; ++e) { const bool tk = lv[e] > best; best = tk ? lv[e] : best; bi = tk ? e : bi; }
                        tv[k] = best; se[k] = bi;
#pragma unroll
                        for (int e = 0; e < 32; ++e) lv[e] = (e == bi) ? -3.0e38f : lv[e]; }
                    const float e1 = fast_exp2((tv[1] - tv[0]) * LOG2E), e2 = fast_exp2((tv[2] - tv[0]) * LOG2E), e3 = fast_exp2((tv[3] - tv[0]) * LOG2E);
                    const float inv = 1.0f / (1.0f + e1 + e2 + e3);
                    sg[0] = inv; sg[1] = e1 * inv; sg[2] = e2 * inv; sg[3] = e3 * inv;
#pragma unroll
                    for (int k = 0; k < 4; ++k) sl[k] = __hip_atomic_fetch_add((LAS unsigned*)(lcnt + se[k]), 1u, __ATOMIC_RELAXED, __HIP_MEMORY_SCOPE_WORKGROUP);
                }
            }
            __syncthreads();
            if (tid < 32) { const unsigned c = lcnt[tid]; lbase[tid] = c ? __hip_atomic_fetch_add(ctl + CW_CNT + 64 * tid, c, RLX_AGENT) : 0u; }
            __syncthreads();
            if (active && lane < 16) {
                const int t = m0 + lane; u32x4 tk;
#pragma unroll
                for (int k = 0; k < 4; ++k) { const unsigned pos = lbase[se[k]] + sl[k]; perm[(size_t)se[k] * 32768 + pos] = t; sgate[(size_t)se[k] * 32768 + pos] = sg[k]; tk[k] = ((unsigned)se[k] << 16) | pos; }
                *(u32x4*)(tok + (size_t)t * 4) = tk;
            }
            __syncthreads();
        }
        if (BOTH(5)) GRID_BAR();
    }

    if (IN(6) || IN(7) || IN(8)) {
        if (threadIdx.x == 0) { int p = 0;
            for (int e = 0; e < 32; ++e) { const int c = (int)__hip_atomic_load(ctl + CW_CNT + 64 * e, RLX_AGENT); MISC[8 + e] = (unsigned)p; MISC[48 + e] = (unsigned)c; p += (c + 255) >> 8; }
            MISC[8 + 32] = (unsigned)p; }
        __syncthreads();
    }
    const LAS int* pref = (const LAS int*)(MISC + 8); const LAS int* ecnt = (const LAS int*)(MISC + 48);

    if (IN(6)) {
        SchedMoe<true> S{(const char*)(ws + WS_X1B), (const char*)(ws + WS_WGU), (const int*)(ws + WS_PERM), pref, ecnt, 8, G, bx, (size_t)2048 * 1024, (size_t)256 * 1024};
        S.reps = (DUP_PHASE == 6) ? 2 : 1; EpiAct E{ws + WS_ACT, args.in[I_BGU]};
        pg8::gemm_phase<EpiAct, SchedMoe<true>, true, false, true>(lds, wave, 512, 512, 512, S, E);
        if (BOTH(6)) GRID_BAR();
    }

    if (IN(7)) {
        SchedMoe<false> S{(const char*)(ws + WS_ACT), (const char*)(ws + WS_WDN), (const int*)(ws + WS_PERM), pref, ecnt, 4, G, bx, (size_t)1024 * 1024, (size_t)256 * 1024};
        S.reps = (DUP_PHASE == 7) ? 2 : 1; EpiDown E{ws + WS_EO, args.in[I_BDN], (const float*)(ws + WS_SGATE), pref};
        pg8::gemm_phase<EpiDown, SchedMoe<false>, true, PG8_SP2, true>(lds, wave, 512, 512, 512, S, E);
        if (BOTH(7)) GRID_BAR();
    }

    if (IN(8)) {
        FRESH_IDS();
        const unsigned char* eo = ws + WS_EO; const unsigned* tok = (const unsigned*)(ws + WS_TOK); const float* sgp = (const float*)(ws + WS_SGATE);
        const float* g2 = args.in[I_LN2G]; const float* b2 = args.in[I_LN2B];
        const int nrow = (T - gw + NGW - 1) / NGW;
        f32x4 gg[4], bb[4];
#pragma unroll
        for (int j = 0; j < 4; ++j) { gg[j] = ((const f32x4*)g2)[lane + 64 * j]; bb[j] = ((const f32x4*)b2)[lane + 64 * j]; }
        for (int k0 = 0; k0 < nrow; k0 += 64) {
            u32x4 tkv = (u32x4){0u, 0u, 0u, 0u}; if (k0 + lane < nrow) tkv = *(const u32x4*)(tok + (size_t)(gw + (k0 + lane) * NGW) * 4);
            const int kend = (nrow - k0) < 64 ? (nrow - k0) : 64;
            for (int kk = 0; kk < kend; kk += 2) {
                u32x2 ld[2][4]; unsigned l8[2][4][4]; float gk[2][4]; int mrow[2]; bool act2[2];
#pragma unroll
                for (int h = 0; h < 2; ++h) { const int kr = kk + h; act2[h] = kr < kend; const int krc = act2[h] ? kr : kk; mrow[h] = gw + (k0 + krc) * NGW;
                    const u32x2* hr = (const u32x2*)((const bf16_t*)(ws + WS_X1H) + (size_t)mrow[h] * D) + lane;
#pragma unroll
                    for (int j = 0; j < 4; ++j) ld[h][j] = hr[64 * j];
#pragma unroll
                    for (int q = 0; q < 4; ++q) { const unsigned tw = (unsigned)__builtin_amdgcn_readlane((int)tkv[q], krc); const unsigned e = tw >> 16, pos = tw & 0xffffu; const size_t slot = (size_t)pref[e] * 256 + pos;
                        gk[h][q] = sgp[(size_t)e * 32768 + pos] * EO8_INV;
                        const unsigned* er = (const unsigned*)(eo + slot * D) + lane;
#pragma unroll
                        for (int j = 0; j < 4; ++j) l8[h][q][j] = __builtin_nontemporal_load(er + 64 * j); } }
#pragma unroll
                for (int h = 0; h < 2; ++h) { if (!act2[h]) continue;
                    f32x4 v[4];
#pragma unroll
                    for (int j = 0; j < 4; ++j) { const u32x2 w = ld[h][j]; v[j].x = bf_lo(w.x) * ALPHA; v[j].y = bf_hi(w.x) * ALPHA; v[j].z = bf_lo(w.y) * ALPHA; v[j].w = bf_hi(w.y) * ALPHA; }
#pragma unroll
                    for (int q = 0; q < 4; ++q)
#pragma unroll
                        for (int j = 0; j < 4; ++j) { const int w = (int)l8[h][q][j]; const f32x2 lo = __builtin_amdgcn_cvt_pk_f32_fp8(w, false), hi = __builtin_amdgcn_cvt_pk_f32_fp8(w, true);
                            v[j].x += lo.x * gk[h][q]; v[j].y += lo.y * gk[h][q]; v[j].z += hi.x * gk[h][q]; v[j].w += hi.y * gk[h][q]; }
                    float s = 0.f;
#pragma unroll
                    for (int j = 0; j < 4; ++j) s += (v[j].x + v[j].y) + (v[j].z + v[j].w);
                    const float mean = wave_sum(s) * (1.f / D); float s2 = 0.f;
#pragma unroll
                    for (int j = 0; j < 4; ++j) { v[j] = v[j] - mean; s2 += (v[j].x * v[j].x + v[j].y * v[j].y) + (v[j].z * v[j].z + v[j].w * v[j].w); }
                    const float rstd = 1.f / sqrtf(wave_sum(s2) * (1.f / D) + LN_EPS);
                    f32x4* xr = (f32x4*)(args.out + (size_t)mrow[h] * D) + lane;
#pragma unroll
                    for (int j = 0; j < 4; ++j) __builtin_nontemporal_store(v[j] * rstd * gg[j] + bb[j], xr + 64 * j); }
            }
        }
    }
#undef IN
#undef BOTH
#undef GRID_BAR
}


extern "C" void kernel_launch(void* const* d_in, const int* in_sizes, int n_in, void* d_out, int out_size, void* d_ws, size_t ws_size, hipStream_t stream) {
    static int grid = 0;
    if (grid == 0) {
        if (n_in != 26 || out_size != T * D || ws_size < WS_END) { fprintf(stderr, "kernel_launch: unexpected shapes (n_in %d, out %d, ws %zu)\n", n_in, out_size, ws_size); grid = -1; return; }
        int dev = 0, cus = 0, per_cu = 0;
        if (hipGetDevice(&dev) != hipSuccess || hipDeviceGetAttribute(&cus, hipDeviceAttributeMultiprocessorCount, dev) != hipSuccess) { grid = -1; return; }
        if (hipFuncSetAttribute((const void*)fwd, hipFuncAttributeMaxDynamicSharedMemorySize, LDS_BYTES) != hipSuccess) { fprintf(stderr, "kernel_launch: hipFuncSetAttribute failed\n"); grid = -1; return; }
        if (hipOccupancyMaxActiveBlocksPerMultiprocessor(&per_cu, (const void*)fwd, NTHR, LDS_BYTES) != hipSuccess || per_cu < 1) fprintf(stderr, "kernel_launch: occupancy query reports %d\n", per_cu);
        (void)hipGetLastError();
        grid = cus;
    }
    if (grid < 0) return;
    (void)hipMemsetAsync((char*)d_ws + WS_CTL, 0, CTL_ZERO_BYTES, stream);
    Args a{};
    for (int i = 0; i < 26; ++i) a.in[i] = (const float*)d_in[i];
    a.out = (float*)d_out; a.ws = (unsigned char*)d_ws;
    if (MK_N_LAUNCHES == 1) { a.ph_lo = 0; a.ph_hi = NPH; hipLaunchKernelGGL(fwd, dim3(grid), dim3(NTHR), LDS_BYTES, stream, a); }
    else for (int p = 0; p < NPH; ++p) { a.ph_lo = p; a.ph_hi = p + 1; hipLaunchKernelGGL(fwd, dim3(grid), dim3(NTHR), LDS_BYTES, stream, a);
    }
}
```
